# Optimizing an MI355X kernel written in HIP

```python
import jax, jax.numpy as jnp
from jax import lax
import numpy as np

D_MODEL = 1024
BATCH = 4
SEQ = 8192
DEPTH = 1
DEC_BATCH = 16
DEC_SEQ = 4096
PAST_LEN = 128

D_MIX = D_MODEL
D_ATTN = D_MIX // 2
D_GMLP = D_MIX - D_ATTN
HEAD_DIM = 64
N_Q_HEADS = D_ATTN // HEAD_DIM
N_KV_HEADS = 2
Q_PER_KV = N_Q_HEADS // N_KV_HEADS
ROT_DIM = HEAD_DIM // 4
ROPE_THETA = 500000.0
WINDOW = 128
BLOCK = 128
N_GMLP_GROUPS = 8
GMLP_GROUP_DIM = D_GMLP // N_GMLP_GROUPS
CHUNK = 128
D_FF = 2816
CONV_W = 3
EPS = 1e-6
D_Q = N_Q_HEADS * HEAD_DIM
D_KV = N_KV_HEADS * HEAD_DIM
D_IN_PROJ = D_Q + 2 * D_KV + 2 * D_GMLP

kernel_name = "hymba_gmlp_swa_convffn_encoder"


def _rmsnorm(x, g):
    xf = x.astype(jnp.float32)
    y = xf * lax.rsqrt(jnp.mean(xf * xf, axis=-1, keepdims=True) + EPS)
    return (y * g.astype(jnp.float32)).astype(x.dtype)


def _layernorm(x, g, b):
    xf = x.astype(jnp.float32)
    mu = jnp.mean(xf, axis=-1, keepdims=True)
    var = jnp.mean(jnp.square(xf - mu), axis=-1, keepdims=True)
    y = (xf - mu) * lax.rsqrt(var + EPS)
    return (y * g.astype(jnp.float32) + b.astype(jnp.float32)).astype(x.dtype)


def _partial_rope(x):
    L = x.shape[1]
    half = ROT_DIM // 2
    inv_freq = ROPE_THETA ** (-jnp.arange(0, ROT_DIM, 2, dtype=jnp.float32) / ROT_DIM)
    ang = jnp.arange(L, dtype=jnp.float32)[:, None] * inv_freq[None, :]
    cos = jnp.cos(ang)[None, :, None, :]
    sin = jnp.sin(ang)[None, :, None, :]
    xr = x[..., :ROT_DIM].astype(jnp.float32)
    x1, x2 = xr[..., :half], xr[..., half:]
    rot = jnp.concatenate([x1 * cos - x2 * sin, x2 * cos + x1 * sin], axis=-1)
    return jnp.concatenate([rot.astype(x.dtype), x[..., ROT_DIM:]], axis=-1)


def _windowed_gqa(q, k, v, sink):
    B, L = q.shape[0], q.shape[1]
    nb = L // BLOCK
    qb = q.reshape(B, nb, BLOCK, N_KV_HEADS, Q_PER_KV, HEAD_DIM)
    pad = ((0, 0), (1, 1), (0, 0), (0, 0), (0, 0))
    kp = jnp.pad(k.reshape(B, nb, BLOCK, N_KV_HEADS, HEAD_DIM), pad)
    vp = jnp.pad(v.reshape(B, nb, BLOCK, N_KV_HEADS, HEAD_DIM), pad)
    kb = jnp.concatenate([kp[:, :-2], kp[:, 1:-1], kp[:, 2:]], axis=2)
    vb = jnp.concatenate([vp[:, :-2], vp[:, 1:-1], vp[:, 2:]], axis=2)
    scale = HEAD_DIM ** -0.5
    scores = jnp.einsum('bnqkgd,bnskd->bnkgqs', qb, kb,
                        preferred_element_type=jnp.float32) * scale
    a = jnp.arange(BLOCK)[:, None]
    s = jnp.arange(3 * BLOCK)[None, :]
    band = jnp.abs(s - BLOCK - a) <= WINDOW
    kpos = jnp.arange(nb)[:, None] * BLOCK - BLOCK + jnp.arange(3 * BLOCK)[None, :]
    inside = (kpos >= 0) & (kpos < L)
    mask = band[None, :, :] & inside[:, None, :]
    scores = jnp.where(mask[None, :, None, None, :, :], scores, jnp.finfo(jnp.float32).min)
    sink_b = jnp.broadcast_to(sink.astype(jnp.float32).reshape(1, 1, N_KV_HEADS, Q_PER_KV, 1, 1),
                              scores.shape[:-1] + (1,))
    p = jax.nn.softmax(jnp.concatenate([scores, sink_b], axis=-1), axis=-1)[..., :-1]
    out = jnp.einsum('bnkgqs,bnskd->bnqkgd', p.astype(v.dtype), vb)
    return out.reshape(B, L, D_ATTN)


def _chunked_gmlp(u, v, ln_g, ln_b, w_s, b_s):
    B, L = u.shape[0], u.shape[1]
    nc = L // CHUNK
    u = jax.nn.gelu(u, approximate=False)
    v = _layernorm(jax.nn.gelu(v, approximate=False), ln_g, ln_b)
    vc = v.reshape(B, nc, CHUNK, N_GMLP_GROUPS, GMLP_GROUP_DIM)
    sg = jnp.einsum('gij,bcjgd->bcigd', w_s, vc) + b_s.T[None, None, :, :, None]
    out = u.reshape(B, nc, CHUNK, N_GMLP_GROUPS, GMLP_GROUP_DIM) * sg
    return out.reshape(B, L, D_GMLP)


def _dwconv3(h, w, b):
    hp = jnp.pad(h, ((0, 0), (1, 1), (0, 0)))
    return hp[:, :-2] * w[0] + hp[:, 1:-1] * w[1] + hp[:, 2:] * w[2] + b


def _layer(x, norm_mix_pre, w_in, attn_sink, gmlp_ln_g, gmlp_ln_b, gmlp_w_s, gmlp_b_s,
           out_norm_attn, out_norm_gmlp, w_o, norm_mix_post, norm_ffn_pre, w_ffn_in,
           conv_w, conv_b, w_ffn_out, norm_ffn_post):
    B, L, _ = x.shape
    h = _rmsnorm(x, norm_mix_pre)
    p = h @ w_in
    o1 = D_Q
    o2 = o1 + D_KV
    o3 = o2 + D_KV
    o4 = o3 + D_GMLP
    q = _partial_rope(p[..., :o1].reshape(B, L, N_Q_HEADS, HEAD_DIM))
    k = _partial_rope(p[..., o1:o2].reshape(B, L, N_KV_HEADS, HEAD_DIM))
    v = p[..., o2:o3].reshape(B, L, N_KV_HEADS, HEAD_DIM)
    attn = _windowed_gqa(q, k, v, attn_sink)
    gm = _chunked_gmlp(p[..., o3:o4], p[..., o4:], gmlp_ln_g, gmlp_ln_b, gmlp_w_s, gmlp_b_s)
    mixed = jnp.concatenate([_rmsnorm(attn, out_norm_attn), _rmsnorm(gm, out_norm_gmlp)], axis=-1)
    x = x + _rmsnorm(mixed @ w_o, norm_mix_post)
    h = _rmsnorm(x, norm_ffn_pre)
    up = _dwconv3(h @ w_ffn_in, conv_w, conv_b)
    f = jax.nn.silu(up[..., :D_FF]) * up[..., D_FF:]
    x = x + _rmsnorm(f @ w_ffn_out, norm_ffn_post)
    return x


def _trunk(x, norm_mix_pre, w_in, attn_sink, gmlp_ln_g, gmlp_ln_b, gmlp_w_s, gmlp_b_s,
           out_norm_attn, out_norm_gmlp, w_o, norm_mix_post, norm_ffn_pre, w_ffn_in,
           conv_w, conv_b, w_ffn_out, norm_ffn_post):
    for l in range(DEPTH):
        x = _layer(x, norm_mix_pre[l], w_in[l], attn_sink[l], gmlp_ln_g[l], gmlp_ln_b[l],
                   gmlp_w_s[l], gmlp_b_s[l], out_norm_attn[l], out_norm_gmlp[l], w_o[l],
                   norm_mix_post[l], norm_ffn_pre[l], w_ffn_in[l], conv_w[l], conv_b[l],
                   w_ffn_out[l], norm_ffn_post[l])
    return x


def setup_inputs(seed: int = 0) -> dict:
    key = jax.random.key(seed)
    ks = jax.random.split(key, 20)
    f32 = jnp.float32

    def nrm(k, shape, scale):
        return jax.random.normal(k, shape, f32) * scale

    def gain(k, shape):
        return 1.0 + 0.05 * jax.random.normal(k, shape, f32)

    return {
        "x_prompt": nrm(ks[0], (BATCH, SEQ, D_MODEL), 1.0),
        "x_sample": nrm(ks[1], (DEC_BATCH, DEC_SEQ, D_MODEL), 1.0),
        "norm_mix_pre": gain(ks[2], (DEPTH, D_MODEL)),
        "w_in": nrm(ks[3], (DEPTH, D_MODEL, D_IN_PROJ), D_MODEL ** -0.5),
        "attn_sink": nrm(ks[4], (DEPTH, N_Q_HEADS), 0.5),
        "gmlp_ln_g": gain(ks[5], (DEPTH, D_GMLP)),
        "gmlp_ln_b": nrm(ks[6], (DEPTH, D_GMLP), 0.02),
        "gmlp_w_s": nrm(ks[7], (DEPTH, N_GMLP_GROUPS, CHUNK, CHUNK), CHUNK ** -0.5),
        "gmlp_b_s": 1.0 + nrm(ks[8], (DEPTH, N_GMLP_GROUPS, CHUNK), 0.02),
        "out_norm_attn": gain(ks[9], (DEPTH, D_ATTN)),
        "out_norm_gmlp": gain(ks[10], (DEPTH, D_GMLP)),
        "w_o": nrm(ks[11], (DEPTH, D_MIX, D_MODEL), D_MIX ** -0.5),
        "norm_mix_post": gain(ks[12], (DEPTH, D_MODEL)),
        "norm_ffn_pre": gain(ks[13], (DEPTH, D_MODEL)),
        "w_ffn_in": nrm(ks[14], (DEPTH, D_MODEL, 2 * D_FF), D_MODEL ** -0.5),
        "conv_w": nrm(ks[15], (DEPTH, CONV_W, 2 * D_FF), CONV_W ** -0.5),
        "conv_b": nrm(ks[16], (DEPTH, 2 * D_FF), 0.02),
        "w_ffn_out": nrm(ks[17], (DEPTH, D_FF, D_MODEL), D_FF ** -0.5),
        "norm_ffn_post": gain(ks[18], (DEPTH, D_MODEL)),
    }


def reference(x_prompt, x_sample, norm_mix_pre, w_in, attn_sink, gmlp_ln_g, gmlp_ln_b,
              gmlp_w_s, gmlp_b_s, out_norm_attn, out_norm_gmlp, w_o, norm_mix_post,
              norm_ffn_pre, w_ffn_in, conv_w, conv_b, w_ffn_out, norm_ffn_post):
    y_prompt = _trunk(x_prompt, norm_mix_pre, w_in, attn_sink, gmlp_ln_g, gmlp_ln_b,
                      gmlp_w_s, gmlp_b_s, out_norm_attn, out_norm_gmlp, w_o, norm_mix_post,
                      norm_ffn_pre, w_ffn_in, conv_w, conv_b, w_ffn_out, norm_ffn_post)
    y_sample = _trunk(x_sample, norm_mix_pre, w_in, attn_sink, gmlp_ln_g, gmlp_ln_b,
                      gmlp_w_s, gmlp_b_s, out_norm_attn, out_norm_gmlp, w_o, norm_mix_post,
                      norm_ffn_pre, w_ffn_in, conv_w, conv_b, w_ffn_out, norm_ffn_post)
    return (y_prompt, y_sample)
```

```cpp
#include <hip/hip_runtime.h>
#include <hip/hip_cooperative_groups.h>
#include <cstdio>
#include <cstdint>
namespace cg = cooperative_groups;
namespace pg8 {
#define PG8_LAS __attribute__((address_space(3)))
typedef unsigned short bf16_t;
typedef short bf16x8 __attribute__((ext_vector_type(8)));
typedef float f32x4 __attribute__((ext_vector_type(4)));
typedef unsigned u32x4 __attribute__((ext_vector_type(4)));
constexpr int BM = 256, BK = 64, HALF = 128, HTB = HALF * BK * 2  , STAGE_BYTES = 8 * HTB, NXCD = 8, WGM = 8;

__host__ __device__ __forceinline__ int lds_byte(int r, int c) { const int st = (r >> 4) * 2 + (c >> 5), rr = r & 15, cc = c & 31, ob = rr * 64 + cc * 2; return st * 1024 + (ob ^ (((ob >> 9) & 1) << 5)); }
__host__ __device__ __forceinline__ void stage_rc(int b, int& R, int& C) { const int st = b / 1024, sb = b % 1024, swz = sb ^ (((sb >> 9) & 1) << 5); R = (st >> 1) * 16 + swz / 64; C = (st & 1) * 32 + (swz % 64) / 2; }
__host__ __device__ __forceinline__ int perm32(int rho) { const int n = rho >> 4, i = rho & 15; return 8 * (i >> 2) + 4 * n + (i & 3); }

struct Unit { int pm, pn; };
struct Gemm { const bf16_t* A; const bf16_t* Bt; int M, N, K; };

struct StaticOrder {
    int nM, nN, nwg, G, c;
    __host__ __device__ void init(int M, int N, int G_, int c_) { nM = M / BM; nN = N / BM; nwg = nM * nN; G = G_; c = c_; }
    __host__ __device__ bool next(int i, Unit& u) const {
        const long L = (long)i * G + c; if (L >= nwg) return false;
        int wgid = (int)L; { const int q = nwg / NXCD, r = nwg % NXCD, xcd = wgid % NXCD, off = wgid / NXCD; wgid = (xcd < r ? xcd * (q + 1) : r * (q + 1) + (xcd - r) * q) + off; }
        const int nig = WGM * nN, gid = wgid / nig, fm = gid * WGM, gsz = (nM - fm) < WGM ? (nM - fm) : WGM;
        u.pm = fm + ((wgid % nig) % gsz); u.pn = (wgid % nig) / gsz; return true;
    }
    __device__ __forceinline__ void a_ready(const Unit&) const {}
    __device__ __forceinline__ void done(const Unit&) const {}
};

__device__ __forceinline__ unsigned cvt_pk_bf16(float lo, float hi) { unsigned r; asm volatile("v_cvt_pk_bf16_f32 %0, %1, %2" : "=v"(r) : "v"(lo), "v"(hi)); return r; }
typedef float f32x2 __attribute__((ext_vector_type(2)));
__device__ __forceinline__ f32x2 gelu_pk(f32x2 v) {
    const f32x2 av = __builtin_elementwise_abs(v), d = av * 0.2316418882f + 1.0f;
    f32x2 t; t.x = __builtin_amdgcn_rcpf(d.x); t.y = __builtin_amdgcn_rcpf(d.y);
    f32x2 q = t * 0.5307027145f + (-0.7265760135f); q = q * t + 0.7107068705f; q = q * t + (-0.142248368f); q = q * t + 0.127414796f; q = q * t;
    const f32x2 s = (v * v) * (-0.72134752044f);
    f32x2 e; e.x = __builtin_amdgcn_exp2f(s.x); e.y = __builtin_amdgcn_exp2f(s.y);
    const f32x2 m = v * (q * e), r = v - m;
    f32x2 o; o.x = v.x < 0.f ? m.x : r.x; o.y = v.y < 0.f ? m.y : r.y; return o;
}

template <int ACT  > struct EpiBf16 {
    static constexpr bool PERM = true, AFTER_DRAIN = false; static_assert(ACT == 0 || ACT == 1, "EpiBf16: ACT is 0 (none) or 1 (gelu_pk)");
    bf16_t* O; int ldc; const float* bias; int split_cols; size_t split_stride; float scale0;
    __device__ __forceinline__ void operator()(const f32x4 (&acc)[2][2][4][2], const Unit& u, int wr, int wc, int fr, int fq) const {
        const int row0 = u.pm * BM + wr * 64 + fr; int colt = u.pn * BM; bf16_t* base = O;
        float sc = 1.f; if (split_cols) { const int t = colt / split_cols; base += (size_t)t * split_stride; colt -= t * split_cols; if (t == 0) sc = scale0; }
        const int col0 = colt + wc * 32 + 8 * fq, bcol0 = u.pn * BM + wc * 32 + 8 * fq;
        f32x4 bv[2][2];
#pragma unroll
        for (int bj = 0; bj < 2; ++bj)
#pragma unroll
            for (int n = 0; n < 2; ++n) bv[bj][n] = bias ? *(const f32x4*)(bias + bcol0 + bj * HALF + 4 * n) : (f32x4){0.f, 0.f, 0.f, 0.f};
#pragma unroll
        for (int ai = 0; ai < 2; ++ai)
#pragma unroll
            for (int m = 0; m < 4; ++m) { bf16_t* rowp = base + (size_t)(row0 + ai * HALF + m * 16) * ldc + col0;
#pragma unroll
                for (int bj = 0; bj < 2; ++bj) { f32x4 v0 = acc[ai][bj][m][0] + bv[bj][0], v1 = acc[ai][bj][m][1] + bv[bj][1];
                    if (ACT == 1) { f32x2 a = gelu_pk((f32x2){v0[0], v0[1]}), b = gelu_pk((f32x2){v0[2], v0[3]}), c = gelu_pk((f32x2){v1[0], v1[1]}), d = gelu_pk((f32x2){v1[2], v1[3]});
                        v0 = (f32x4){a.x, a.y, b.x, b.y}; v1 = (f32x4){c.x, c.y, d.x, d.y}; }
                    v0 = v0 * sc; v1 = v1 * sc; u32x4 w; w.x = cvt_pk_bf16(v0[0], v0[1]); w.y = cvt_pk_bf16(v0[2], v0[3]); w.z = cvt_pk_bf16(v1[0], v1[1]); w.w = cvt_pk_bf16(v1[2], v1[3]);
                    *(u32x4*)(rowp + bj * HALF) = w; } }
    }
};
template <class Epi, class Sched, bool ALIGN_EPI = false, bool SP2 = false>
__device__ __forceinline__ void gemm_phase(PG8_LAS unsigned char* lds, const Gemm g, const Sched& S, const Epi& E) {
    const int tid = threadIdx.x, wid = __builtin_amdgcn_readfirstlane(tid >> 6), lane = tid & 63, wr = wid >> 2, wc = wid & 3, fr = lane & 15, fq = lane >> 4;
    const int K = g.K, nt = K / BK;
    unsigned voffA[2], voffB[2];
#pragma unroll
    for (int i = 0; i < 2; ++i) { int R, C; stage_rc(tid * 16 + i * 8192, R, C); const int Rb = Epi::PERM ? ((R & ~31) + perm32(R & 31)) : R;
        voffA[i] = (unsigned)(R * K + C) * 2u; voffB[i] = (unsigned)(Rb * K + C) * 2u; }
    const size_t kstep = (size_t)(BK * 2);
    const size_t hstep = (size_t)HALF * K * 2;
    const size_t tstep = 2 * hstep;
    const unsigned ldsw = (unsigned)wid * 1024u;
    const int aoff = lds_byte(wr * 64 + fr, fq * 8), boff = lds_byte(wc * 32 + fr, fq * 8);
#define PG8_SA(b, h) (((b) * 2 + (h)) * HTB)
#define PG8_SB(b, h) ((4 + (b) * 2 + (h)) * HTB)
#define PG8_STAGE(bufoff, gbase, voff) do { _Pragma("unroll") for (int _i = 0; _i < 2; ++_i) \
        __builtin_amdgcn_global_load_lds((const unsigned*)((const char*)(gbase) + (voff)[_i]), (PG8_LAS unsigned*)(lds + (bufoff) + ldsw + _i * 8192), 16, 0, 0); } while (0)
#define PG8_LDA(dst, b, h) do { _Pragma("unroll") for (int m = 0; m < 4; ++m) _Pragma("unroll") for (int k = 0; k < 2; ++k) dst[m][k] = *(const PG8_LAS bf16x8*)(lds + PG8_SA(b, h) + aoff + m * 2048 + k * 1024); } while (0)
#define PG8_LDB(dst, b, h) do { _Pragma("unroll") for (int n = 0; n < 2; ++n) _Pragma("unroll") for (int k = 0; k < 2; ++k) dst[n][k] = *(const PG8_LAS bf16x8*)(lds + PG8_SB(b, h) + boff + n * 2048 + k * 1024); } while (0)
#define PG8_MMA(ai, bj, At, Bt) do { __builtin_amdgcn_s_setprio(1); _Pragma("unroll") for (int m = 0; m < 4; ++m) _Pragma("unroll") for (int n = 0; n < 2; ++n) _Pragma("unroll") for (int k = 0; k < 2; ++k) \
        acc[ai][bj][m][n] = __builtin_amdgcn_mfma_f32_16x16x32_bf16(Bt[n][k], At[m][k], acc[ai][bj][m][n], 0, 0, 0); __builtin_amdgcn_s_setprio(0); } while (0)
#define PG8_WAIT_V(n) asm volatile("s_waitcnt vmcnt(" #n ")" ::: "memory")
#define PG8_WAIT_L(n) asm volatile("s_waitcnt lgkmcnt(" #n ")" ::: "memory")
#define PG8_BAR __builtin_amdgcn_s_barrier()
#define PG8_SCHED __builtin_amdgcn_sched_barrier(0)
    Unit cur, nxt; int ui = 0;
    if (!S.next(0, cur)) return;
    f32x4 acc[2][2][4][2];
#pragma unroll
    for (int a = 0; a < 2; ++a)
#pragma unroll
        for (int b = 0; b < 2; ++b)
#pragma unroll
            for (int m = 0; m < 4; ++m)
#pragma unroll
                for (int n = 0; n < 2; ++n) acc[a][b][m][n] = (f32x4){0.f, 0.f, 0.f, 0.f};
    bf16x8 At[4][2], B0[2][2], B1[2][2];
    const char* cA = (const char*)g.A + (size_t)cur.pm * tstep; const char* cB = (const char*)g.Bt + (size_t)cur.pn * tstep;
    S.a_ready(cur);
    if constexpr (SP2) {
        PG8_STAGE(PG8_SB(0, 0), cB, voffB); PG8_STAGE(PG8_SB(0, 1), cB + hstep, voffB); PG8_STAGE(PG8_SA(0, 0), cA, voffA); PG8_STAGE(PG8_SA(0, 1), cA + hstep, voffA);
        if (wr == 1) PG8_BAR;
        PG8_WAIT_V(2); PG8_BAR;
        PG8_STAGE(PG8_SB(1, 0), cB + kstep, voffB); PG8_STAGE(PG8_SA(1, 0), cA + kstep, voffA); PG8_STAGE(PG8_SB(1, 1), cB + hstep + kstep, voffB);
        PG8_WAIT_V(6); PG8_BAR;
    } else {
        PG8_STAGE(PG8_SB(0, 0), cB, voffB); PG8_STAGE(PG8_SA(0, 0), cA, voffA); PG8_STAGE(PG8_SB(0, 1), cB + hstep, voffB); PG8_STAGE(PG8_SA(0, 1), cA + hstep, voffA);
        if (wr == 1) PG8_BAR;
        PG8_WAIT_V(4); PG8_BAR;
        PG8_STAGE(PG8_SB(1, 0), cB + kstep, voffB); PG8_STAGE(PG8_SA(1, 0), cA + kstep, voffA); PG8_STAGE(PG8_SB(1, 1), cB + hstep + kstep, voffB);
        PG8_WAIT_V(6); PG8_BAR;
    }
    for (;;) {
        const bool has_next = S.next(ui + 1, nxt);
        const char* nA = has_next ? (const char*)g.A + (size_t)nxt.pm * tstep : cA; const char* nB = has_next ? (const char*)g.Bt + (size_t)nxt.pn * tstep : cB;
        for (int t = 0; t < nt; t += 2) {
            const bool last = (t == nt - 2);
            const char* a1 = cA + (size_t)(t + 1) * kstep;
            const char* a2 = last ? nA : cA + (size_t)(t + 2) * kstep; const char* b2 = last ? nB : cB + (size_t)(t + 2) * kstep;
            const char* a3 = a2 + kstep; const char* b3 = b2 + kstep;
            if (last && has_next) S.a_ready(nxt);
            if constexpr (SP2) {
            PG8_LDB(B0, 0, 0); PG8_LDB(B1, 0, 1); PG8_SCHED; PG8_LDA(At, 0, 0); PG8_STAGE(PG8_SA(1, 1), a1 + hstep, voffA);
            PG8_WAIT_V(8); PG8_WAIT_L(0); PG8_BAR; PG8_MMA(0, 0, At, B0); PG8_MMA(0, 1, At, B1); PG8_BAR; PG8_SCHED;
            PG8_LDA(At, 0, 1); PG8_STAGE(PG8_SB(0, 0), b2, voffB); PG8_STAGE(PG8_SB(0, 1), b2 + hstep, voffB); PG8_STAGE(PG8_SA(0, 0), a2, voffA);
            PG8_WAIT_V(8); PG8_WAIT_L(0); PG8_BAR; PG8_MMA(1, 0, At, B0); PG8_MMA(1, 1, At, B1); PG8_BAR; PG8_SCHED;
            PG8_LDB(B0, 1, 0); PG8_LDB(B1, 1, 1); PG8_SCHED; PG8_LDA(At, 1, 0); PG8_STAGE(PG8_SA(0, 1), a2 + hstep, voffA);
            PG8_WAIT_V(8); PG8_WAIT_L(0); PG8_BAR; PG8_MMA(0, 0, At, B0); PG8_MMA(0, 1, At, B1); PG8_BAR; PG8_SCHED;
            PG8_LDA(At, 1, 1); PG8_STAGE(PG8_SB(1, 0), b3, voffB); PG8_STAGE(PG8_SB(1, 1), b3 + hstep, voffB); PG8_STAGE(PG8_SA(1, 0), a3, voffA);
            PG8_WAIT_V(8); PG8_WAIT_L(0); PG8_BAR; PG8_MMA(1, 0, At, B0); PG8_MMA(1, 1, At, B1); PG8_BAR; PG8_SCHED;
            } else {
            PG8_LDB(B0, 0, 0); PG8_SCHED; PG8_LDA(At, 0, 0); PG8_STAGE(PG8_SA(1, 1), a1 + hstep, voffA);
            PG8_WAIT_L(8); PG8_BAR; PG8_WAIT_L(0); PG8_MMA(0, 0, At, B0); PG8_BAR; PG8_SCHED;
            PG8_LDB(B1, 0, 1); PG8_STAGE(PG8_SB(0, 0), b2, voffB);
            PG8_BAR; PG8_WAIT_L(0); PG8_MMA(0, 1, At, B1); PG8_BAR;
            PG8_LDA(At, 0, 1); PG8_STAGE(PG8_SA(0, 0), a2, voffA);
            PG8_BAR; PG8_WAIT_L(0); PG8_MMA(1, 0, At, B0); PG8_BAR; PG8_SCHED;
            PG8_STAGE(PG8_SB(0, 1), b2 + hstep, voffB);
            PG8_WAIT_V(6); PG8_BAR; PG8_MMA(1, 1, At, B1); PG8_BAR;
            PG8_LDB(B0, 1, 0); PG8_SCHED; PG8_LDA(At, 1, 0); PG8_STAGE(PG8_SA(0, 1), a2 + hstep, voffA);
            PG8_WAIT_L(8); PG8_BAR; PG8_WAIT_L(0); PG8_MMA(0, 0, At, B0); PG8_BAR; PG8_SCHED;
            PG8_LDB(B1, 1, 1); PG8_STAGE(PG8_SB(1, 0), b3, voffB);
            PG8_BAR; PG8_WAIT_L(0); PG8_MMA(0, 1, At, B1); PG8_BAR;
            PG8_LDA(At, 1, 1); PG8_STAGE(PG8_SA(1, 0), a3, voffA);
            PG8_BAR; PG8_WAIT_L(0); PG8_MMA(1, 0, At, B0); PG8_BAR; PG8_SCHED;
            PG8_STAGE(PG8_SB(1, 1), b3 + hstep, voffB);
            PG8_WAIT_V(6); PG8_BAR; PG8_MMA(1, 1, At, B1); PG8_BAR;
            }
        }
        if constexpr (ALIGN_EPI) { if (wr == 0) PG8_BAR; }
        if constexpr (!Epi::AFTER_DRAIN) { E(acc, cur, wr, wc, fr, fq); S.done(cur); }
        if (!has_next) break;
#pragma unroll
        for (int a = 0; a < 2; ++a)
#pragma unroll
            for (int b = 0; b < 2; ++b)
#pragma unroll
                for (int m = 0; m < 4; ++m)
#pragma unroll
                    for (int n = 0; n < 2; ++n) acc[a][b][m][n] = (f32x4){0.f, 0.f, 0.f, 0.f};
        cur = nxt; cA = nA; cB = nB; ++ui;
        if constexpr (ALIGN_EPI) { if (wr == 1) PG8_BAR; }
    }
    PG8_WAIT_V(0);
    if constexpr (!ALIGN_EPI) { if (wr == 0) PG8_BAR; }
    PG8_BAR;
    if constexpr (Epi::AFTER_DRAIN) { E.fused(acc, cur, wr, wc, fr, fq, lds, wid, lane); S.done(cur); }
#undef PG8_SA
#undef PG8_SB
#undef PG8_STAGE
#undef PG8_LDA
#undef PG8_LDB
#undef PG8_MMA
#undef PG8_WAIT_V
#undef PG8_WAIT_L
#undef PG8_BAR
#undef PG8_SCHED
}
}

constexpr int DM = 1024, T1 = 4 * 8192, T2 = 16 * 4096, TT = T1 + T2;
constexpr int L1 = 8192, L2 = 4096;
constexpr int NIN = 1792, DFF = 2816, NF1 = 2 * DFF;
constexpr int OQ = 0, OK_ = 512, OV = 640, OU = 768, OVG = 1280;
constexpr float EPS = 1e-6f;
constexpr int NTHR = 512;
typedef unsigned short bf16;
typedef short bf16x8 __attribute__((ext_vector_type(8)));
typedef float f32x4 __attribute__((ext_vector_type(4)));
typedef unsigned u32x4 __attribute__((ext_vector_type(4)));
typedef unsigned u32x2 __attribute__((ext_vector_type(2)));
#define LAS __attribute__((address_space(3)))

constexpr size_t MiB = 1u << 20;
constexpr size_t WS_WIN = 1 * MiB;
constexpr size_t WS_WO = 5 * MiB;
constexpr size_t WS_WF1 = 7 * MiB;
constexpr size_t WS_WF2 = 18 * MiB;
constexpr size_t WS_WS = 24 * MiB;
constexpr size_t WS_ROPE = 25 * MiB;
constexpr size_t WS_ST = 26 * MiB;
constexpr size_t WS_R0 = 32 * MiB;
constexpr size_t WS_R1 = 224 * MiB;
constexpr size_t WS_R2 = 560 * MiB;
constexpr size_t WS_R3 = 752 * MiB;
constexpr size_t WS_F = 416 * MiB;
constexpr size_t WS_END = 960 * MiB;

struct Params {
    const float* xp; const float* xs;
    const float* g_mix_pre; const float* w_in; const float* sink; const float* ln_g; const float* ln_b; const float* w_s; const float* b_s;
    const float* g_attn; const float* g_gmlp; const float* w_o; const float* g_mix_post; const float* g_ffn_pre; const float* w_f1;
    const float* conv_w; const float* conv_b; const float* w_f2; const float* g_ffn_post;
    float* out; unsigned char* ws;
    int ph_lo, ph_hi;
};

__device__ __forceinline__ float bf2f(bf16 b) { return __uint_as_float((unsigned)b << 16); }
__device__ __forceinline__ unsigned f2bf(float f) { unsigned u = __float_as_uint(f); return (u + 0x7fffu + ((u >> 16) & 1u)) >> 16; }
__device__ __forceinline__ unsigned pk2(float lo, float hi) { return f2bf(lo) | (f2bf(hi) << 16); }
__device__ __forceinline__ float wave_sum(float v) {
#pragma unroll
    for (int o = 1; o < 64; o <<= 1) v += __shfl_xor(v, o);
    return v;
}
__device__ __forceinline__ const float* xrow(const Params& p, int r) { return r < T1 ? p.xp + (size_t)r * DM : p.xs + (size_t)(r - T1) * DM; }
__device__ __forceinline__ int seqlen(int r) { return r < T1 ? L1 : L2; }
__device__ __forceinline__ float gelu_exact(float x) { return 0.5f * x * (1.0f + erff(x * 0.70710678118654752f)); }

template <bool F1PERM>
__device__ __forceinline__ void transpose_item(const float* W, int K, int N, bf16* WT, LAS float* scr, int item, int lane) {
    const int nblk = N / 32, kb = item / nblk, nb = item % nblk, k0 = 64 * kb, n0 = 32 * nb;
#pragma unroll 8
    for (int i = 0; i < 32; ++i) { const int kk = 2 * i + (lane >> 5); scr[kk * 33 + (lane & 31)] = W[(size_t)(k0 + kk) * N + n0 + (lane & 31)]; }
    asm volatile("s_waitcnt lgkmcnt(0)" ::: "memory");
    const int c = lane & 7;
#pragma unroll
    for (int j = 0; j < 4; ++j) { const int n = (lane >> 3) + 8 * j; const LAS float* s = scr + (8 * c) * 33 + n;
        u32x4 o; o.x = pk2(s[0 * 33], s[1 * 33]); o.y = pk2(s[2 * 33], s[3 * 33]); o.z = pk2(s[4 * 33], s[5 * 33]); o.w = pk2(s[6 * 33], s[7 * 33]);
        int nr = n0 + n;
        if (F1PERM) { const int half = nr >= DFF ? 1 : 0, ch = nr - half * DFF; nr = (ch >> 7) * 256 + half * 128 + (ch & 127); }
        *(u32x4*)(WT + (size_t)nr * K + k0 + 8 * c) = o; }
    asm volatile("s_waitcnt lgkmcnt(0)" ::: "memory");
}
__device__ __forceinline__ void rms_row_to_bf16(const float* xr_, const float* g, bf16* orow, int lane) {
    const f32x4* xr = (const f32x4*)xr_ + lane; const f32x4* gr = (const f32x4*)g + lane;
    f32x4 v[4]; float s = 0.f;
#pragma unroll
    for (int j = 0; j < 4; ++j) { v[j] = xr[64 * j]; s += (v[j].x * v[j].x + v[j].y * v[j].y) + (v[j].z * v[j].z + v[j].w * v[j].w); }
    const float rstd = 1.f / sqrtf(wave_sum(s) * (1.f / DM) + EPS);
    u32x2* o8 = (u32x2*)orow + lane;
#pragma unroll
    for (int j = 0; j < 4; ++j) { const f32x4 gg = gr[64 * j]; u32x2 w; w.x = pk2(v[j].x * rstd * gg.x, v[j].y * rstd * gg.y); w.y = pk2(v[j].z * rstd * gg.z, v[j].w * rstd * gg.w); o8[64 * j] = w; }
}
__device__ __forceinline__ void phase_prologue(const Params& p, LAS unsigned char* lds) {
    const int tid = threadIdx.x, lane = tid & 63, wave = tid >> 6;
    LAS float* scr = (LAS float*)(lds + wave * 16384);
    const int gw = blockIdx.x * 8 + wave, NGW = gridDim.x * 8;
    bf16* WtIn = (bf16*)(p.ws + WS_WIN); bf16* WtO = (bf16*)(p.ws + WS_WO); bf16* WtF1 = (bf16*)(p.ws + WS_WF1); bf16* WtF2 = (bf16*)(p.ws + WS_WF2);
    constexpr int I_IN = (DM / 64) * (NIN / 32), I_O = (DM / 64) * (DM / 32), I_F1 = (DM / 64) * (NF1 / 32), I_F2 = (DFF / 64) * (DM / 32);
    constexpr int NITEMS = I_IN + I_O + I_F1 + I_F2;
    for (int it = gw; it < NITEMS; it += NGW) {
        int r = it;
        if (r < I_IN) { transpose_item<false>(p.w_in, DM, NIN, WtIn, scr, r, lane); continue; } r -= I_IN;
        if (r < I_O) { transpose_item<false>(p.w_o, DM, DM, WtO, scr, r, lane); continue; } r -= I_O;
        if (r < I_F1) { transpose_item<true>(p.w_f1, DM, NF1, WtF1, scr, r, lane); continue; } r -= I_F1;
        transpose_item<false>(p.w_f2, DFF, DM, WtF2, scr, r, lane);
    }
    const int gt = blockIdx.x * NTHR + tid, NGT = gridDim.x * NTHR;
    bf16* WsB = (bf16*)(p.ws + WS_WS);
    for (int i = gt; i < 8 * 128 * 128; i += NGT) WsB[i] = (bf16)f2bf(p.w_s[i]);
    float* rope = (float*)(p.ws + WS_ROPE);
    for (int i = gt; i < 8192 * 8; i += NGT) { const int pos = i >> 3, j = i & 7; const float inv = powf(500000.0f, -(float)(2 * j) / 16.0f); const float ang = (float)pos * inv; float sn, cs; sincosf(ang, &sn, &cs); rope[2 * i] = cs; rope[2 * i + 1] = sn; }
    bf16* XN = (bf16*)(p.ws + WS_R0);
    for (int m = gw; m < TT; m += NGW) rms_row_to_bf16(xrow(p, m), p.g_mix_pre, XN + (size_t)m * DM, lane);
}

__device__ __forceinline__ void phase_e1(const Params& p) {
    bf16* P = (bf16*)(p.ws + WS_R1); const float* rope = (const float*)(p.ws + WS_ROPE);
    const size_t gt = (size_t)blockIdx.x * NTHR + threadIdx.x, NGT = (size_t)gridDim.x * NTHR;
    for (size_t i = gt; i < (size_t)TT * 80; i += NGT) {
        const int r = (int)(i / 80), e = (int)(i % 80), hh = e >> 3, j = e & 7; const int pos = r & (seqlen(r) - 1);
        bf16* q = P + (size_t)r * NIN + hh * 64 + j; const float x1 = bf2f(q[0]), x2 = bf2f(q[8]);
        const float cs = rope[(pos * 8 + j) * 2], sn = rope[(pos * 8 + j) * 2 + 1];
        q[0] = (bf16)f2bf(x1 * cs - x2 * sn); q[8] = (bf16)f2bf(x2 * cs + x1 * sn);
    }
    for (size_t i = gt; i < (size_t)TT * 1024; i += NGT) {
        const int r = (int)(i >> 10), c = (int)(i & 1023); bf16* q = P + (size_t)r * NIN + OU + c; q[0] = (bf16)f2bf(gelu_exact(bf2f(q[0])));
    }
}
__device__ __forceinline__ void phase_attn_naive(const Params& p) {
    const bf16* P = (const bf16*)(p.ws + WS_R1); float* AT = (float*)(p.ws + WS_R2);
    const size_t gt = (size_t)blockIdx.x * NTHR + threadIdx.x, NGT = (size_t)gridDim.x * NTHR;
    for (size_t i = gt; i < (size_t)TT * 8; i += NGT) {
        const int h = (int)(i % 8); const int r = (int)(i / 8); const int L = seqlen(r), pos = r & (L - 1), kvh = h >> 2;
        float q[64], o[64];
        const bf16* qp = P + (size_t)r * NIN + h * 64;
#pragma unroll
        for (int d = 0; d < 64; ++d) { q[d] = bf2f(qp[d]) * 0.125f; o[d] = 0.f; }
        float m = p.sink[h], l = 1.0f;
        const int k0 = pos - 128 < 0 ? 0 : pos - 128, k1 = pos + 128 > L - 1 ? L - 1 : pos + 128;
        for (int kp = k0; kp <= k1; ++kp) {
            const bf16* kr = P + (size_t)(r + kp - pos) * NIN + OK_ + kvh * 64; const bf16* vr = P + (size_t)(r + kp - pos) * NIN + OV + kvh * 64;
            float s = 0.f;
#pragma unroll
            for (int d = 0; d < 64; ++d) s += q[d] * bf2f(kr[d]);
            const float mn = fmaxf(m, s), a = __expf(m - mn), e = __expf(s - mn);
            l = l * a + e; m = mn;
#pragma unroll
            for (int d = 0; d < 64; ++d) o[d] = o[d] * a + e * bf2f(vr[d]);
        }
        const float il = 1.0f / l; float* op = AT + (size_t)r * 512 + h * 64;
#pragma unroll
        for (int d = 0; d < 64; ++d) op[d] = o[d] * il;
    }
}
__device__ __forceinline__ void phase_gmlp_stats(const Params& p) {
    const bf16* P = (const bf16*)(p.ws + WS_R1); float* ST = (float*)(p.ws + WS_ST);
    const int lane = threadIdx.x & 63, gw = blockIdx.x * 8 + (threadIdx.x >> 6), NGW = gridDim.x * 8;
    for (int r = gw; r < TT; r += NGW) {
        const bf16* v = P + (size_t)r * NIN + OVG; float x[8]; float s = 0.f;
#pragma unroll
        for (int j = 0; j < 8; ++j) { x[j] = bf2f(v[lane + 64 * j]); s += x[j]; }
        const float mu = wave_sum(s) * (1.f / 512.f); float q = 0.f;
#pragma unroll
        for (int j = 0; j < 8; ++j) { const float d = x[j] - mu; q += d * d; }
        const float rstd = 1.f / sqrtf(wave_sum(q) * (1.f / 512.f) + EPS);
        if (lane == 0) { ST[2 * r] = mu; ST[2 * r + 1] = rstd; }
    }
}
__device__ __forceinline__ void phase_gmlp_naive(const Params& p) {
    const bf16* P = (const bf16*)(p.ws + WS_R1); const float* ST = (const float*)(p.ws + WS_ST); float* GM = (float*)(p.ws + WS_R3);
    const size_t gt = (size_t)blockIdx.x * NTHR + threadIdx.x, NGT = (size_t)gridDim.x * NTHR;
    for (size_t idx = gt; idx < (size_t)TT * 512; idx += NGT) {
        const int c = (int)(idx & 511), r = (int)(idx >> 9), i = r & 127, rb = r - i, g = c >> 6;
        const float lg = p.ln_g[c], lb = p.ln_b[c]; const float* w = p.w_s + ((size_t)g * 128 + i) * 128;
        float s = 0.f;
        for (int j = 0; j < 128; ++j) { const float vv = bf2f(P[(size_t)(rb + j) * NIN + OVG + c]); s += w[j] * ((vv - ST[2 * (rb + j)]) * ST[2 * (rb + j) + 1] * lg + lb); }
        GM[idx] = bf2f(P[(size_t)r * NIN + OU + c]) * (s + p.b_s[g * 128 + i]);
    }
}
__device__ __forceinline__ void phase_mixnorm(const Params& p) {
    const float* AT = (const float*)(p.ws + WS_R2); const float* GM = (const float*)(p.ws + WS_R3); bf16* MIX = (bf16*)(p.ws + WS_R0);
    const int lane = threadIdx.x & 63, gw = blockIdx.x * 8 + (threadIdx.x >> 6), NGW = gridDim.x * 8;
    for (int r = gw; r < TT; r += NGW) {
#pragma unroll
        for (int part = 0; part < 2; ++part) {
            const float* src = (part ? GM : AT) + (size_t)r * 512; const float* g = part ? p.g_gmlp : p.g_attn;
            float x[8]; float s = 0.f;
#pragma unroll
            for (int j = 0; j < 8; ++j) { x[j] = src[lane + 64 * j]; s += x[j] * x[j]; }
            const float rstd = 1.f / sqrtf(wave_sum(s) * (1.f / 512.f) + EPS);
#pragma unroll
            for (int j = 0; j < 8; ++j) MIX[(size_t)r * DM + part * 512 + lane + 64 * j] = (bf16)f2bf(x[j] * rstd * g[lane + 64 * j]);
        }
    }
}
__device__ __forceinline__ void phase_r3(const Params& p) {
    const bf16* M = (const bf16*)(p.ws + WS_R1); bf16* H2 = (bf16*)(p.ws + WS_R0);
    const int lane = threadIdx.x & 63, gw = blockIdx.x * 8 + (threadIdx.x >> 6), NGW = gridDim.x * 8;
    for (int r = gw; r < TT; r += NGW) {
        const f32x4* xr = (const f32x4*)xrow(p, r) + lane; const u32x2* mr = (const u32x2*)(M + (size_t)r * DM) + lane;
        f32x4 mv[4], xv[4]; float s = 0.f;
#pragma unroll
        for (int j = 0; j < 4; ++j) { const u32x2 w = mr[64 * j]; mv[j] = (f32x4){__uint_as_float(w.x << 16), __uint_as_float(w.x & 0xffff0000u), __uint_as_float(w.y << 16), __uint_as_float(w.y & 0xffff0000u)};
            xv[j] = xr[64 * j]; s += (mv[j].x * mv[j].x + mv[j].y * mv[j].y) + (mv[j].z * mv[j].z + mv[j].w * mv[j].w); }
        const float rstd = 1.f / sqrtf(wave_sum(s) * (1.f / DM) + EPS); float s2 = 0.f;
        f32x4* orow = (f32x4*)(p.out + (size_t)r * DM) + lane;
#pragma unroll
        for (int j = 0; j < 4; ++j) { const f32x4 g = ((const f32x4*)p.g_mix_post)[lane + 64 * j]; xv[j] = xv[j] + mv[j] * rstd * g; orow[64 * j] = xv[j];
            s2 += (xv[j].x * xv[j].x + xv[j].y * xv[j].y) + (xv[j].z * xv[j].z + xv[j].w * xv[j].w); }
        const float rstd2 = 1.f / sqrtf(wave_sum(s2) * (1.f / DM) + EPS);
        u32x2* o8 = (u32x2*)(H2 + (size_t)r * DM) + lane;
#pragma unroll
        for (int j = 0; j < 4; ++j) { const f32x4 g = ((const f32x4*)p.g_ffn_pre)[lane + 64 * j]; u32x2 w; w.x = pk2(xv[j].x * rstd2 * g.x, xv[j].y * rstd2 * g.y); w.y = pk2(xv[j].z * rstd2 * g.z, xv[j].w * rstd2 * g.w); o8[64 * j] = w; }
    }
}
constexpr int ZCH = 16384;
__device__ __forceinline__ void phase_conv_naive(const Params& p, int chunk) {
    const bf16* Z = (const bf16*)(p.ws + WS_R1); bf16* F = (bf16*)(p.ws + WS_F);
    const size_t gt = (size_t)blockIdx.x * NTHR + threadIdx.x, NGT = (size_t)gridDim.x * NTHR;
    for (size_t idx = gt; idx < (size_t)ZCH * DFF; idx += NGT) {
        const int c = (int)(idx % DFF), lr = (int)(idx / DFF), r = chunk * ZCH + lr; const int L = seqlen(r), pos = r & (L - 1);
        const int cg_ = (c >> 7) * 256 + (c & 127), cu = cg_ + 128;
        const bf16* z = Z + (size_t)lr * NF1;
        const bool hl = pos > 0, hr = pos < L - 1;
        const float g0 = hl ? bf2f(z[cg_ - NF1]) : 0.f, g1 = bf2f(z[cg_]), g2 = hr ? bf2f(z[cg_ + NF1]) : 0.f;
        const float u0 = hl ? bf2f(z[cu - NF1]) : 0.f, u1 = bf2f(z[cu]), u2 = hr ? bf2f(z[cu + NF1]) : 0.f;
        const float* cw = p.conv_w;
        const float gg = g0 * cw[c] + g1 * cw[NF1 + c] + g2 * cw[2 * NF1 + c] + p.conv_b[c];
        const float uu = u0 * cw[DFF + c] + u1 * cw[NF1 + DFF + c] + u2 * cw[2 * NF1 + DFF + c] + p.conv_b[DFF + c];
        const float sl = gg / (1.0f + __expf(-gg));
        F[(size_t)r * DFF + c] = (bf16)f2bf(sl * uu);
    }
}
__device__ __forceinline__ void phase_r6(const Params& p) {
    const bf16* Y = (const bf16*)(p.ws + WS_R0);
    const int lane = threadIdx.x & 63, gw = blockIdx.x * 8 + (threadIdx.x >> 6), NGW = gridDim.x * 8;
    for (int r = gw; r < TT; r += NGW) {
        const u32x2* mr = (const u32x2*)(Y + (size_t)r * DM) + lane; f32x4* orow = (f32x4*)(p.out + (size_t)r * DM) + lane;
        f32x4 mv[4], xv[4]; float s = 0.f;
#pragma unroll
        for (int j = 0; j < 4; ++j) { const u32x2 w = mr[64 * j]; mv[j] = (f32x4){__uint_as_float(w.x << 16), __uint_as_float(w.x & 0xffff0000u), __uint_as_float(w.y << 16), __uint_as_float(w.y & 0xffff0000u)};
            xv[j] = orow[64 * j]; s += (mv[j].x * mv[j].x + mv[j].y * mv[j].y) + (mv[j].z * mv[j].z + mv[j].w * mv[j].w); }
        const float rstd = 1.f / sqrtf(wave_sum(s) * (1.f / DM) + EPS);
#pragma unroll
        for (int j = 0; j < 4; ++j) { const f32x4 g = ((const f32x4*)p.g_ffn_post)[lane + 64 * j]; orow[64 * j] = xv[j] + mv[j] * rstd * g; }
    }
}

constexpr int LDS_BYTES = 147456;
template <class Epi>
__device__ __forceinline__ void run_gemm(LAS unsigned char* lds, const bf16* A, const bf16* Bt, int M, int N, int K, const Epi& E) {
    pg8::Gemm g{A, Bt, M, N, K}; pg8::StaticOrder S; S.init(M, N, (int)gridDim.x, (int)blockIdx.x);
    pg8::gemm_phase<Epi, pg8::StaticOrder, true, true>(lds, g, S, E);
}
constexpr int NPHASE = 22;
__global__ void __launch_bounds__(NTHR, 2) mega_fwd(Params p) {
    extern __shared__ __attribute__((aligned(16))) unsigned char lds_raw[];
    LAS unsigned char* lds = (LAS unsigned char*)lds_raw;
    cg::grid_group grid = cg::this_grid();
    unsigned char* ws = p.ws;
    const int lo = p.ph_lo, hi = p.ph_hi;
#define IN(k) (lo <= (k) && (k) < hi)
#define SEAM(k) do { if (IN(k) && IN((k) + 1)) grid.sync(); } while (0)
    if (IN(0)) phase_prologue(p, lds);
    SEAM(0);
    if (IN(1)) { pg8::EpiBf16<0> E{(bf16*)(ws + WS_R1), NIN, nullptr, 0, 0, 1.f}; run_gemm(lds, (const bf16*)(ws + WS_R0), (const bf16*)(ws + WS_WIN), TT, NIN, DM, E); }
    SEAM(1);
    if (IN(2)) phase_e1(p);
    SEAM(2);
    if (IN(3)) { phase_attn_naive(p); phase_gmlp_stats(p); }
    SEAM(3);
    if (IN(4)) phase_gmlp_naive(p);
    SEAM(4);
    if (IN(5)) phase_mixnorm(p);
    SEAM(5);
    if (IN(6)) { pg8::EpiBf16<0> E{(bf16*)(ws + WS_R1), DM, nullptr, 0, 0, 1.f}; run_gemm(lds, (const bf16*)(ws + WS_R0), (const bf16*)(ws + WS_WO), TT, DM, DM, E); }
    SEAM(6);
    if (IN(7)) phase_r3(p);
    SEAM(7);
    for (int c = 0; c < 6; ++c) {
        if (IN(8 + 2 * c)) { pg8::EpiBf16<0> E{(bf16*)(ws + WS_R1), NF1, nullptr, 0, 0, 1.f}; run_gemm(lds, (const bf16*)(ws + WS_R0) + (size_t)c * ZCH * DM, (const bf16*)(ws + WS_WF1), ZCH, NF1, DM, E); }
        SEAM(8 + 2 * c);
        if (IN(9 + 2 * c)) phase_conv_naive(p, c);
        SEAM(9 + 2 * c);
    }
    if (IN(20)) { pg8::EpiBf16<0> E{(bf16*)(ws + WS_R0), DM, nullptr, 0, 0, 1.f}; run_gemm(lds, (const bf16*)(ws + WS_F), (const bf16*)(ws + WS_WF2), TT, DM, DFF, E); }
    SEAM(20);
    if (IN(21)) phase_r6(p);
}

extern "C" void kernel_launch(void* const* d_in, const int* in_sizes, int n_in, void* d_out, int out_size, void* d_ws, size_t ws_size, hipStream_t stream) {
    static int grid = 0;
    if (grid == 0) {
        if (n_in != 19 || out_size != TT * DM || ws_size < WS_END) { fprintf(stderr, "kernel_launch: unexpected shapes n_in %d out %d ws %zu\n", n_in, out_size, ws_size); grid = -1; return; }
        int dev = 0, cus = 0, per_cu = 0;
        (void)hipGetDevice(&dev); (void)hipDeviceGetAttribute(&cus, hipDeviceAttributeMultiprocessorCount, dev);
        if (hipFuncSetAttribute((const void*)mega_fwd, hipFuncAttributeMaxDynamicSharedMemorySize, LDS_BYTES) != hipSuccess) { fprintf(stderr, "hipFuncSetAttribute failed\n"); grid = -1; return; }
        if (hipOccupancyMaxActiveBlocksPerMultiprocessor(&per_cu, (const void*)mega_fwd, NTHR, LDS_BYTES) != hipSuccess || per_cu < 1) { fprintf(stderr, "occupancy query: %d\n", per_cu); per_cu = 1; }
        (void)hipGetLastError();
        grid = cus * 1;
    }
    if (grid < 0) return;
    Params p{};
    p.xp = (const float*)d_in[0]; p.xs = (const float*)d_in[1]; p.g_mix_pre = (const float*)d_in[2]; p.w_in = (const float*)d_in[3]; p.sink = (const float*)d_in[4];
    p.ln_g = (const float*)d_in[5]; p.ln_b = (const float*)d_in[6]; p.w_s = (const float*)d_in[7]; p.b_s = (const float*)d_in[8]; p.g_attn = (const float*)d_in[9];
    p.g_gmlp = (const float*)d_in[10]; p.w_o = (const float*)d_in[11]; p.g_mix_post = (const float*)d_in[12]; p.g_ffn_pre = (const float*)d_in[13]; p.w_f1 = (const float*)d_in[14];
    p.conv_w = (const float*)d_in[15]; p.conv_b = (const float*)d_in[16]; p.w_f2 = (const float*)d_in[17]; p.g_ffn_post = (const float*)d_in[18];
    p.out = (float*)d_out; p.ws = (unsigned char*)d_ws;
#if defined(MULTI_LAUNCH)
    for (int ph = 0; ph < NPHASE; ++ph) { p.ph_lo = ph; p.ph_hi = ph + 1; hipLaunchKernelGGL(mega_fwd, dim3(grid), dim3(NTHR), LDS_BYTES, stream, p); }
#else
    p.ph_lo = 0; p.ph_hi = NPHASE;
    void* args[] = {&p};
    hipError_t e = hipLaunchCooperativeKernel((const void*)mega_fwd, dim3(grid), dim3(NTHR), args, LDS_BYTES, stream);
    if (e != hipSuccess) fprintf(stderr, "cooperative launch failed: %s (grid %d)\n", hipGetErrorString(e), grid);
#endif
}
```

```cpp
#include <hip/hip_runtime.h>
#include <hip/hip_cooperative_groups.h>
#include <cstdio>
#include <cstdint>
namespace cg = cooperative_groups;
namespace pg8 {
#define PG8_LAS __attribute__((address_space(3)))
typedef unsigned short bf16_t;
typedef short bf16x8 __attribute__((ext_vector_type(8)));
typedef float f32x4 __attribute__((ext_vector_type(4)));
typedef unsigned u32x4 __attribute__((ext_vector_type(4)));
constexpr int BM = 256, BK = 64, HALF = 128, HTB = HALF * BK * 2  , STAGE_BYTES = 8 * HTB, NXCD = 8, WGM = 8;

__host__ __device__ __forceinline__ int lds_byte(int r, int c) { const int st = (r >> 4) * 2 + (c >> 5), rr = r & 15, cc = c & 31, ob = rr * 64 + cc * 2; return st * 1024 + (ob ^ (((ob >> 9) & 1) << 5)); }
__host__ __device__ __forceinline__ void stage_rc(int b, int& R, int& C) { const int st = b / 1024, sb = b % 1024, swz = sb ^ (((sb >> 9) & 1) << 5); R = (st >> 1) * 16 + swz / 64; C = (st & 1) * 32 + (swz % 64) / 2; }
__host__ __device__ __forceinline__ int perm32(int rho) { const int n = rho >> 4, i = rho & 15; return 8 * (i >> 2) + 4 * n + (i & 3); }

struct Unit { int pm, pn; };
struct Gemm { const bf16_t* A; const bf16_t* Bt; int M, N, K; int a_wrs = 64, a_hrows = 128, a_trows = 256; };

struct StaticOrder {
    int nM, nN, nwg, G, c;
    __host__ __device__ void init(int M, int N, int G_, int c_) { nM = M / BM; nN = N / BM; nwg = nM * nN; G = G_; c = c_; }
    __host__ __device__ bool next(int i, Unit& u) const {
        const long L = (long)i * G + c; if (L >= nwg) return false;
        int wgid = (int)L; { const int q = nwg / NXCD, r = nwg % NXCD, xcd = wgid % NXCD, off = wgid / NXCD; wgid = (xcd < r ? xcd * (q + 1) : r * (q + 1) + (xcd - r) * q) + off; }
        const int nig = WGM * nN, gid = wgid / nig, fm = gid * WGM, gsz = (nM - fm) < WGM ? (nM - fm) : WGM;
        u.pm = fm + ((wgid % nig) % gsz); u.pn = (wgid % nig) / gsz; return true;
    }
    __device__ __forceinline__ void a_ready(const Unit&) const {}
    __device__ __forceinline__ void done(const Unit&) const {}
};

__device__ __forceinline__ unsigned cvt_pk_bf16(float lo, float hi) { unsigned r; asm volatile("v_cvt_pk_bf16_f32 %0, %1, %2" : "=v"(r) : "v"(lo), "v"(hi)); return r; }
typedef float f32x2 __attribute__((ext_vector_type(2)));
__device__ __forceinline__ f32x2 gelu_pk(f32x2 v) {
    const f32x2 av = __builtin_elementwise_abs(v), d = av * 0.2316418882f + 1.0f;
    f32x2 t; t.x = __builtin_amdgcn_rcpf(d.x); t.y = __builtin_amdgcn_rcpf(d.y);
    f32x2 q = t * 0.5307027145f + (-0.7265760135f); q = q * t + 0.7107068705f; q = q * t + (-0.142248368f); q = q * t + 0.127414796f; q = q * t;
    const f32x2 s = (v * v) * (-0.72134752044f);
    f32x2 e; e.x = __builtin_amdgcn_exp2f(s.x); e.y = __builtin_amdgcn_exp2f(s.y);
    const f32x2 m = v * (q * e), r = v - m;
    f32x2 o; o.x = v.x < 0.f ? m.x : r.x; o.y = v.y < 0.f ? m.y : r.y; return o;
}

template <int ACT  > struct EpiBf16 {
    static constexpr bool PERM = true, AFTER_DRAIN = false; static_assert(ACT == 0 || ACT == 1, "EpiBf16: ACT is 0 (none) or 1 (gelu_pk)");
    bf16_t* O; int ldc; const float* bias; int split_cols; size_t split_stride; float scale0;
    __device__ __forceinline__ void operator()(const f32x4 (&acc)[2][2][4][2], const Unit& u, int wr, int wc, int fr, int fq) const {
        const int row0 = u.pm * BM + wr * 64 + fr; int colt = u.pn * BM; bf16_t* base = O;
        float sc = 1.f; if (split_cols) { const int t = colt / split_cols; base += (size_t)t * split_stride; colt -= t * split_cols; if (t == 0) sc = scale0; }
        const int col0 = colt + wc * 32 + 8 * fq, bcol0 = u.pn * BM + wc * 32 + 8 * fq;
        f32x4 bv[2][2];
#pragma unroll
        for (int bj = 0; bj < 2; ++bj)
#pragma unroll
            for (int n = 0; n < 2; ++n) bv[bj][n] = bias ? *(const f32x4*)(bias + bcol0 + bj * HALF + 4 * n) : (f32x4){0.f, 0.f, 0.f, 0.f};
#pragma unroll
        for (int ai = 0; ai < 2; ++ai)
#pragma unroll
            for (int m = 0; m < 4; ++m) { bf16_t* rowp = base + (size_t)(row0 + ai * HALF + m * 16) * ldc + col0;
#pragma unroll
                for (int bj = 0; bj < 2; ++bj) { f32x4 v0 = acc[ai][bj][m][0] + bv[bj][0], v1 = acc[ai][bj][m][1] + bv[bj][1];
                    if (ACT == 1) { f32x2 a = gelu_pk((f32x2){v0[0], v0[1]}), b = gelu_pk((f32x2){v0[2], v0[3]}), c = gelu_pk((f32x2){v1[0], v1[1]}), d = gelu_pk((f32x2){v1[2], v1[3]});
                        v0 = (f32x4){a.x, a.y, b.x, b.y}; v1 = (f32x4){c.x, c.y, d.x, d.y}; }
                    v0 = v0 * sc; v1 = v1 * sc; u32x4 w; w.x = cvt_pk_bf16(v0[0], v0[1]); w.y = cvt_pk_bf16(v0[2], v0[3]); w.z = cvt_pk_bf16(v1[0], v1[1]); w.w = cvt_pk_bf16(v1[2], v1[3]);
                    *(u32x4*)(rowp + bj * HALF) = w; } }
    }
};
template <class Epi, class Sched, bool ALIGN_EPI = false, bool SP2 = false>
__device__ __forceinline__ void gemm_phase(PG8_LAS unsigned char* lds, const Gemm g, const Sched& S, const Epi& E) {
    const int tid = threadIdx.x, wid = __builtin_amdgcn_readfirstlane(tid >> 6), lane = tid & 63, wr = wid >> 2, wc = wid & 3, fr = lane & 15, fq = lane >> 4;
    const int K = g.K, nt = K / BK;
    unsigned voffA[2], voffB[2];
#pragma unroll
    for (int i = 0; i < 2; ++i) { int R, C; stage_rc(tid * 16 + i * 8192, R, C); const int Rb = Epi::PERM ? ((R & ~31) + perm32(R & 31)) : R;
        voffA[i] = (unsigned)(((R >> 6) * g.a_wrs + (R & 63)) * K + C) * 2u; voffB[i] = (unsigned)(Rb * K + C) * 2u; }
    const size_t kstep = (size_t)(BK * 2);
    const size_t hstep = (size_t)HALF * K * 2;
    const size_t tstep = 2 * hstep;
    const size_t hstepA = (size_t)g.a_hrows * K * 2, tstepA = (size_t)g.a_trows * K * 2;
    const unsigned ldsw = (unsigned)wid * 1024u;
    const int aoff = lds_byte(wr * 64 + fr, fq * 8), boff = lds_byte(wc * 32 + fr, fq * 8);
#define PG8_SA(b, h) (((b) * 2 + (h)) * HTB)
#define PG8_SB(b, h) ((4 + (b) * 2 + (h)) * HTB)
#define PG8_STAGE(bufoff, gbase, voff) do { _Pragma("unroll") for (int _i = 0; _i < 2; ++_i) \
        __builtin_amdgcn_global_load_lds((const unsigned*)((const char*)(gbase) + (voff)[_i]), (PG8_LAS unsigned*)(lds + (bufoff) + ldsw + _i * 8192), 16, 0, 0); } while (0)
#define PG8_LDA(dst, b, h) do { _Pragma("unroll") for (int m = 0; m < 4; ++m) _Pragma("unroll") for (int k = 0; k < 2; ++k) dst[m][k] = *(const PG8_LAS bf16x8*)(lds + PG8_SA(b, h) + aoff + m * 2048 + k * 1024); } while (0)
#define PG8_LDB(dst, b, h) do { _Pragma("unroll") for (int n = 0; n < 2; ++n) _Pragma("unroll") for (int k = 0; k < 2; ++k) dst[n][k] = *(const PG8_LAS bf16x8*)(lds + PG8_SB(b, h) + boff + n * 2048 + k * 1024); } while (0)
#define PG8_MMA(ai, bj, At, Bt) do { __builtin_amdgcn_s_setprio(1); _Pragma("unroll") for (int m = 0; m < 4; ++m) _Pragma("unroll") for (int n = 0; n < 2; ++n) _Pragma("unroll") for (int k = 0; k < 2; ++k) \
        acc[ai][bj][m][n] = __builtin_amdgcn_mfma_f32_16x16x32_bf16(Bt[n][k], At[m][k], acc[ai][bj][m][n], 0, 0, 0); __builtin_amdgcn_s_setprio(0); } while (0)
#define PG8_WAIT_V(n) asm volatile("s_waitcnt vmcnt(" #n ")" ::: "memory")
#define PG8_WAIT_L(n) asm volatile("s_waitcnt lgkmcnt(" #n ")" ::: "memory")
#define PG8_BAR __builtin_amdgcn_s_barrier()
#define PG8_SCHED __builtin_amdgcn_sched_barrier(0)
    Unit cur, nxt; int ui = 0;
    if (!S.next(0, cur)) return;
    f32x4 acc[2][2][4][2];
#pragma unroll
    for (int a = 0; a < 2; ++a)
#pragma unroll
        for (int b = 0; b < 2; ++b)
#pragma unroll
            for (int m = 0; m < 4; ++m)
#pragma unroll
                for (int n = 0; n < 2; ++n) acc[a][b][m][n] = (f32x4){0.f, 0.f, 0.f, 0.f};
    bf16x8 At[4][2], B0[2][2], B1[2][2];
    const char* cA = (const char*)g.A + (size_t)cur.pm * tstepA; const char* cB = (const char*)g.Bt + (size_t)cur.pn * tstep;
    S.a_ready(cur);
    if constexpr (SP2) {
        PG8_STAGE(PG8_SB(0, 0), cB, voffB); PG8_STAGE(PG8_SB(0, 1), cB + hstep, voffB); PG8_STAGE(PG8_SA(0, 0), cA, voffA); PG8_STAGE(PG8_SA(0, 1), cA + hstepA, voffA);
        if (wr == 1) PG8_BAR;
        PG8_WAIT_V(2); PG8_BAR;
        PG8_STAGE(PG8_SB(1, 0), cB + kstep, voffB); PG8_STAGE(PG8_SA(1, 0), cA + kstep, voffA); PG8_STAGE(PG8_SB(1, 1), cB + hstep + kstep, voffB);
        PG8_WAIT_V(6); PG8_BAR;
    } else {
        PG8_STAGE(PG8_SB(0, 0), cB, voffB); PG8_STAGE(PG8_SA(0, 0), cA, voffA); PG8_STAGE(PG8_SB(0, 1), cB + hstep, voffB); PG8_STAGE(PG8_SA(0, 1), cA + hstepA, voffA);
        if (wr == 1) PG8_BAR;
        PG8_WAIT_V(4); PG8_BAR;
        PG8_STAGE(PG8_SB(1, 0), cB + kstep, voffB); PG8_STAGE(PG8_SA(1, 0), cA + kstep, voffA); PG8_STAGE(PG8_SB(1, 1), cB + hstep + kstep, voffB);
        PG8_WAIT_V(6); PG8_BAR;
    }
    for (;;) {
        const bool has_next = S.next(ui + 1, nxt);
        const char* nA = has_next ? (const char*)g.A + (size_t)nxt.pm * tstepA : cA; const char* nB = has_next ? (const char*)g.Bt + (size_t)nxt.pn * tstep : cB;
        for (int t = 0; t < nt; t += 2) {
            const bool last = (t == nt - 2);
            const char* a1 = cA + (size_t)(t + 1) * kstep;
            const char* a2 = last ? nA : cA + (size_t)(t + 2) * kstep; const char* b2 = last ? nB : cB + (size_t)(t + 2) * kstep;
            const char* a3 = a2 + kstep; const char* b3 = b2 + kstep;
            if (last && has_next) S.a_ready(nxt);
            if constexpr (SP2) {
            PG8_LDB(B0, 0, 0); PG8_LDB(B1, 0, 1); PG8_SCHED; PG8_LDA(At, 0, 0); PG8_STAGE(PG8_SA(1, 1), a1 + hstepA, voffA);
            PG8_WAIT_V(8); PG8_WAIT_L(0); PG8_BAR; PG8_MMA(0, 0, At, B0); PG8_MMA(0, 1, At, B1); PG8_BAR; PG8_SCHED;
            PG8_LDA(At, 0, 1); PG8_STAGE(PG8_SB(0, 0), b2, voffB); PG8_STAGE(PG8_SB(0, 1), b2 + hstep, voffB); PG8_STAGE(PG8_SA(0, 0), a2, voffA);
            PG8_WAIT_V(8); PG8_WAIT_L(0); PG8_BAR; PG8_MMA(1, 0, At, B0); PG8_MMA(1, 1, At, B1); PG8_BAR; PG8_SCHED;
            PG8_LDB(B0, 1, 0); PG8_LDB(B1, 1, 1); PG8_SCHED; PG8_LDA(At, 1, 0); PG8_STAGE(PG8_SA(0, 1), a2 + hstepA, voffA);
            PG8_WAIT_V(8); PG8_WAIT_L(0); PG8_BAR; PG8_MMA(0, 0, At, B0); PG8_MMA(0, 1, At, B1); PG8_BAR; PG8_SCHED;
            PG8_LDA(At, 1, 1); PG8_STAGE(PG8_SB(1, 0), b3, voffB); PG8_STAGE(PG8_SB(1, 1), b3 + hstep, voffB); PG8_STAGE(PG8_SA(1, 0), a3, voffA);
            PG8_WAIT_V(8); PG8_WAIT_L(0); PG8_BAR; PG8_MMA(1, 0, At, B0); PG8_MMA(1, 1, At, B1); PG8_BAR; PG8_SCHED;
            } else {
            PG8_LDB(B0, 0, 0); PG8_SCHED; PG8_LDA(At, 0, 0); PG8_STAGE(PG8_SA(1, 1), a1 + hstepA, voffA);
            PG8_WAIT_L(8); PG8_BAR; PG8_WAIT_L(0); PG8_MMA(0, 0, At, B0); PG8_BAR; PG8_SCHED;
            PG8_LDB(B1, 0, 1); PG8_STAGE(PG8_SB(0, 0), b2, voffB);
            PG8_BAR; PG8_WAIT_L(0); PG8_MMA(0, 1, At, B1); PG8_BAR;
            PG8_LDA(At, 0, 1); PG8_STAGE(PG8_SA(0, 0), a2, voffA);
            PG8_BAR; PG8_WAIT_L(0); PG8_MMA(1, 0, At, B0); PG8_BAR; PG8_SCHED;
            PG8_STAGE(PG8_SB(0, 1), b2 + hstep, voffB);
            PG8_WAIT_V(6); PG8_BAR; PG8_MMA(1, 1, At, B1); PG8_BAR;
            PG8_LDB(B0, 1, 0); PG8_SCHED; PG8_LDA(At, 1, 0); PG8_STAGE(PG8_SA(0, 1), a2 + hstepA, voffA);
            PG8_WAIT_L(8); PG8_BAR; PG8_WAIT_L(0); PG8_MMA(0, 0, At, B0); PG8_BAR; PG8_SCHED;
            PG8_LDB(B1, 1, 1); PG8_STAGE(PG8_SB(1, 0), b3, voffB);
            PG8_BAR; PG8_WAIT_L(0); PG8_MMA(0, 1, At, B1); PG8_BAR;
            PG8_LDA(At, 1, 1); PG8_STAGE(PG8_SA(1, 0), a3, voffA);
            PG8_BAR; PG8_WAIT_L(0); PG8_MMA(1, 0, At, B0); PG8_BAR; PG8_SCHED;
            PG8_STAGE(PG8_SB(1, 1), b3 + hstep, voffB);
            PG8_WAIT_V(6); PG8_BAR; PG8_MMA(1, 1, At, B1); PG8_BAR;
            }
        }
        if constexpr (ALIGN_EPI) { if (wr == 0) PG8_BAR; }
        if constexpr (!Epi::AFTER_DRAIN) { E(acc, cur, wr, wc, fr, fq); S.done(cur); }
        if (!has_next) break;
#pragma unroll
        for (int a = 0; a < 2; ++a)
#pragma unroll
            for (int b = 0; b < 2; ++b)
#pragma unroll
                for (int m = 0; m < 4; ++m)
#pragma unroll
                    for (int n = 0; n < 2; ++n) acc[a][b][m][n] = (f32x4){0.f, 0.f, 0.f, 0.f};
        cur = nxt; cA = nA; cB = nB; ++ui;
        if constexpr (ALIGN_EPI) { if (wr == 1) PG8_BAR; }
    }
    PG8_WAIT_V(0);
    if constexpr (!ALIGN_EPI) { if (wr == 0) PG8_BAR; }
    PG8_BAR;
    if constexpr (Epi::AFTER_DRAIN) { E.fused(acc, cur, wr, wc, fr, fq, lds, wid, lane); S.done(cur); }
#undef PG8_SA
#undef PG8_SB
#undef PG8_STAGE
#undef PG8_LDA
#undef PG8_LDB
#undef PG8_MMA
#undef PG8_WAIT_V
#undef PG8_WAIT_L
#undef PG8_BAR
#undef PG8_SCHED
}
}

namespace pg8 {
template <int CTRL> __device__ __forceinline__ float dpp0(float v) { return __int_as_float(__builtin_amdgcn_update_dpp(0, __float_as_int(v), CTRL, 0xf, 0xf, true)); }
struct EpiConvSilu {
    static constexpr bool PERM = true, AFTER_DRAIN = false;
    bf16_t* F; const float* cw; const float* cb; int dff, nrows, t1;
    template <bool MASKED>
    __device__ __forceinline__ void core(const f32x4 (&acc)[2][2][4][2], int t0, int i0, int ch0, int fr) const {
        f32x4 w0[2][2], w1[2][2], w2[2][2], bb[2][2];
#pragma unroll
        for (int bj = 0; bj < 2; ++bj)
#pragma unroll
            for (int n = 0; n < 2; ++n) { const int c = bj * dff + ch0 + 4 * n;
                w0[bj][n] = *(const f32x4*)(cw + c); w1[bj][n] = *(const f32x4*)(cw + 2 * dff + c); w2[bj][n] = *(const f32x4*)(cw + 4 * dff + c); bb[bj][n] = *(const f32x4*)(cb + c); }
#pragma unroll
        for (int ai = 0; ai < 2; ++ai)
#pragma unroll
            for (int m = 0; m < 4; ++m) {
                const int i = 64 * ai + 16 * m + fr, t = t0 + i;
                float ml = 1.f, mr = 1.f;
                if (MASKED) { ml = (i == i0) ? 0.f : 1.f; mr = (i == i0 - 1) ? 0.f : 1.f; }
                float cv[2][2][4];
#pragma unroll
                for (int bj = 0; bj < 2; ++bj)
#pragma unroll
                    for (int n = 0; n < 2; ++n)
#pragma unroll
                        for (int e = 0; e < 4; ++e) {
                            const float v = acc[ai][bj][m][n][e];
                            float wl = w0[bj][n][e], wr_ = w2[bj][n][e];
                            if (MASKED) { wl *= ml; wr_ *= mr; }
                            float c = __builtin_fmaf(w1[bj][n][e], v, bb[bj][n][e]);
                            c = __builtin_fmaf(wl, dpp0<0x111>(v), c);
                            c = __builtin_fmaf(wr_, dpp0<0x101>(v), c);
                            if (m > 0) c = __builtin_fmaf(wl, dpp0<0x10F>(acc[ai][bj][m - 1][n][e]), c);
                            else if (ai == 1) c = __builtin_fmaf(wl, dpp0<0x10F>(acc[0][bj][3][n][e]), c);
                            if (m < 3) c = __builtin_fmaf(wr_, dpp0<0x11F>(acc[ai][bj][m + 1][n][e]), c);
                            else if (ai == 0) c = __builtin_fmaf(wr_, dpp0<0x11F>(acc[1][bj][0][n][e]), c);
                            cv[bj][n][e] = c;
                        }
                float f[2][4];
#pragma unroll
                for (int n = 0; n < 2; ++n)
#pragma unroll
                    for (int e = 0; e < 4; ++e) { const float gte = cv[0][n][e]; const float sg = gte * __builtin_amdgcn_rcpf(1.0f + __builtin_amdgcn_exp2f(-1.4426950408889634f * gte)); f[n][e] = sg * cv[1][n][e]; }
                u32x4 o; o.x = cvt_pk_bf16(f[0][0], f[0][1]); o.y = cvt_pk_bf16(f[0][2], f[0][3]); o.z = cvt_pk_bf16(f[1][0], f[1][1]); o.w = cvt_pk_bf16(f[1][2], f[1][3]);
                const bool ok = (i >= 1) && (i <= 126) && (t < nrows);
                if (ok) *(u32x4*)(F + (size_t)t * dff + ch0) = o;
            }
    }
    __device__ __forceinline__ void operator()(const f32x4 (&acc)[2][2][4][2], const Unit& u, int wr, int wc, int fr, int fq) const {
        const int ch0 = u.pn * 128 + wc * 32 + 8 * fq, t0 = u.pm * 252 - 1 + wr * 126;
        const int s = (t0 + 4096) & ~4095, i0 = s - t0;
        const bool has = (i0 <= 127) && (s <= nrows) && (s >= t1 || (s & 8191) == 0);
        if (has) core<true>(acc, t0, i0, ch0, fr); else core<false>(acc, t0, i0, ch0, fr);
    }
};
}

constexpr int DM = 1024, T1 = 4 * 8192, T2 = 16 * 4096, TT = T1 + T2;
constexpr int L1 = 8192, L2 = 4096;
constexpr int NIN = 1792, DFF = 2816, NF1 = 2 * DFF;
constexpr int OQ = 0, OK_ = 512, OV = 640, OU = 768, OVG = 1280;
constexpr float EPS = 1e-6f;
constexpr int NTHR = 512;
typedef unsigned short bf16;
typedef short bf16x8 __attribute__((ext_vector_type(8)));
typedef float f32x4 __attribute__((ext_vector_type(4)));
typedef unsigned u32x4 __attribute__((ext_vector_type(4)));
typedef unsigned u32x2 __attribute__((ext_vector_type(2)));
#define LAS __attribute__((address_space(3)))

constexpr size_t MiB = 1u << 20;
constexpr size_t WS_WIN = 1 * MiB;
constexpr size_t WS_WO = 5 * MiB;
constexpr size_t WS_WF1 = 7 * MiB;
constexpr size_t WS_WF2 = 18 * MiB;
constexpr size_t WS_WS = 24 * MiB;
constexpr size_t WS_ROPE = 25 * MiB;
constexpr size_t WS_ST = 26 * MiB;
constexpr size_t WS_R0 = 32 * MiB;
constexpr size_t WS_R1 = 224 * MiB;
constexpr size_t WS_R2 = 560 * MiB;
constexpr size_t WS_R3 = 752 * MiB;
constexpr size_t WS_F = 416 * MiB;
constexpr size_t WS_END = 960 * MiB;

struct Params {
    const float* xp; const float* xs;
    const float* g_mix_pre; const float* w_in; const float* sink; const float* ln_g; const float* ln_b; const float* w_s; const float* b_s;
    const float* g_attn; const float* g_gmlp; const float* w_o; const float* g_mix_post; const float* g_ffn_pre; const float* w_f1;
    const float* conv_w; const float* conv_b; const float* w_f2; const float* g_ffn_post;
    float* out; unsigned char* ws;
    int ph_lo, ph_hi;
};

__device__ __forceinline__ float bf2f(bf16 b) { return __uint_as_float((unsigned)b << 16); }
__device__ __forceinline__ unsigned f2bf(float f) { unsigned u = __float_as_uint(f); return (u + 0x7fffu + ((u >> 16) & 1u)) >> 16; }
__device__ __forceinline__ unsigned pk2(float lo, float hi) { return f2bf(lo) | (f2bf(hi) << 16); }
__device__ __forceinline__ float wave_sum(float v) {
#pragma unroll
    for (int o = 1; o < 64; o <<= 1) v += __shfl_xor(v, o);
    return v;
}
__device__ __forceinline__ const float* xrow(const Params& p, int r) { return r < T1 ? p.xp + (size_t)r * DM : p.xs + (size_t)(r - T1) * DM; }
__device__ __forceinline__ int seqlen(int r) { return r < T1 ? L1 : L2; }
__device__ __forceinline__ float gelu_exact(float x) { return 0.5f * x * (1.0f + erff(x * 0.70710678118654752f)); }

template <bool F1PERM>
__device__ __forceinline__ void transpose_item(const float* W, int K, int N, bf16* WT, LAS float* scr, int item, int lane) {
    const int nblk = N / 32, kb = item / nblk, nb = item % nblk, k0 = 64 * kb, n0 = 32 * nb;
#pragma unroll 8
    for (int i = 0; i < 32; ++i) { const int kk = 2 * i + (lane >> 5); scr[kk * 33 + (lane & 31)] = W[(size_t)(k0 + kk) * N + n0 + (lane & 31)]; }
    asm volatile("s_waitcnt lgkmcnt(0)" ::: "memory");
    const int c = lane & 7;
#pragma unroll
    for (int j = 0; j < 4; ++j) { const int n = (lane >> 3) + 8 * j; const LAS float* s = scr + (8 * c) * 33 + n;
        u32x4 o; o.x = pk2(s[0 * 33], s[1 * 33]); o.y = pk2(s[2 * 33], s[3 * 33]); o.z = pk2(s[4 * 33], s[5 * 33]); o.w = pk2(s[6 * 33], s[7 * 33]);
        int nr = n0 + n;
        if (F1PERM) { const int half = nr >= DFF ? 1 : 0, ch = nr - half * DFF; nr = (ch >> 7) * 256 + half * 128 + (ch & 127); }
        *(u32x4*)(WT + (size_t)nr * K + k0 + 8 * c) = o; }
    asm volatile("s_waitcnt lgkmcnt(0)" ::: "memory");
}
__device__ __forceinline__ void rms_row_to_bf16(const float* xr_, const float* g, bf16* orow, int lane) {
    const f32x4* xr = (const f32x4*)xr_ + lane; const f32x4* gr = (const f32x4*)g + lane;
    f32x4 v[4]; float s = 0.f;
#pragma unroll
    for (int j = 0; j < 4; ++j) { v[j] = xr[64 * j]; s += (v[j].x * v[j].x + v[j].y * v[j].y) + (v[j].z * v[j].z + v[j].w * v[j].w); }
    const float rstd = 1.f / sqrtf(wave_sum(s) * (1.f / DM) + EPS);
    u32x2* o8 = (u32x2*)orow + lane;
#pragma unroll
    for (int j = 0; j < 4; ++j) { const f32x4 gg = gr[64 * j]; u32x2 w; w.x = pk2(v[j].x * rstd * gg.x, v[j].y * rstd * gg.y); w.y = pk2(v[j].z * rstd * gg.z, v[j].w * rstd * gg.w); o8[64 * j] = w; }
}
__device__ __forceinline__ void phase_prologue(const Params& p, LAS unsigned char* lds) {
    const int tid = threadIdx.x, lane = tid & 63, wave = tid >> 6;
    LAS float* scr = (LAS float*)(lds + wave * 16384);
    const int gw = blockIdx.x * 8 + wave, NGW = gridDim.x * 8;
    bf16* WtIn = (bf16*)(p.ws + WS_WIN); bf16* WtO = (bf16*)(p.ws + WS_WO); bf16* WtF1 = (bf16*)(p.ws + WS_WF1); bf16* WtF2 = (bf16*)(p.ws + WS_WF2);
    constexpr int I_IN = (DM / 64) * (NIN / 32), I_O = (DM / 64) * (DM / 32), I_F1 = (DM / 64) * (NF1 / 32), I_F2 = (DFF / 64) * (DM / 32);
    constexpr int NITEMS = I_IN + I_O + I_F1 + I_F2;
    for (int it = gw; it < NITEMS; it += NGW) {
        int r = it;
        if (r < I_IN) { transpose_item<false>(p.w_in, DM, NIN, WtIn, scr, r, lane); continue; } r -= I_IN;
        if (r < I_O) { transpose_item<false>(p.w_o, DM, DM, WtO, scr, r, lane); continue; } r -= I_O;
        if (r < I_F1) { transpose_item<true>(p.w_f1, DM, NF1, WtF1, scr, r, lane); continue; } r -= I_F1;
        transpose_item<false>(p.w_f2, DFF, DM, WtF2, scr, r, lane);
    }
    const int gt = blockIdx.x * NTHR + tid, NGT = gridDim.x * NTHR;
    bf16* WsB = (bf16*)(p.ws + WS_WS);
    for (int i = gt; i < 8 * 128 * 128; i += NGT) WsB[i] = (bf16)f2bf(p.w_s[i]);
    float* rope = (float*)(p.ws + WS_ROPE);
    for (int i = gt; i < 8192 * 8; i += NGT) { const int pos = i >> 3, j = i & 7; const float inv = powf(500000.0f, -(float)(2 * j) / 16.0f); const float ang = (float)pos * inv; float sn, cs; sincosf(ang, &sn, &cs); rope[2 * i] = cs; rope[2 * i + 1] = sn; }
    bf16* XN = (bf16*)(p.ws + WS_R0);
    for (int m = gw; m < TT; m += NGW) rms_row_to_bf16(xrow(p, m), p.g_mix_pre, XN + (size_t)m * DM, lane);
}

__device__ __forceinline__ void phase_e1(const Params& p) {
    bf16* P = (bf16*)(p.ws + WS_R1); const float* rope = (const float*)(p.ws + WS_ROPE);
    const size_t gt = (size_t)blockIdx.x * NTHR + threadIdx.x, NGT = (size_t)gridDim.x * NTHR;
    for (size_t i = gt; i < (size_t)TT * 80; i += NGT) {
        const int r = (int)(i / 80), e = (int)(i % 80), hh = e >> 3, j = e & 7; const int pos = r & (seqlen(r) - 1);
        bf16* q = P + (size_t)r * NIN + hh * 64 + j; const float x1 = bf2f(q[0]), x2 = bf2f(q[8]);
        const float cs = rope[(pos * 8 + j) * 2], sn = rope[(pos * 8 + j) * 2 + 1];
        q[0] = (bf16)f2bf(x1 * cs - x2 * sn); q[8] = (bf16)f2bf(x2 * cs + x1 * sn);
    }
    for (size_t i = gt; i < (size_t)TT * 1024; i += NGT) {
        const int r = (int)(i >> 10), c = (int)(i & 1023); bf16* q = P + (size_t)r * NIN + OU + c; q[0] = (bf16)f2bf(gelu_exact(bf2f(q[0])));
    }
}
__device__ __forceinline__ void phase_attn_naive(const Params& p) {
    const bf16* P = (const bf16*)(p.ws + WS_R1); float* AT = (float*)(p.ws + WS_R2);
    const size_t gt = (size_t)blockIdx.x * NTHR + threadIdx.x, NGT = (size_t)gridDim.x * NTHR;
    for (size_t i = gt; i < (size_t)TT * 8; i += NGT) {
        const int h = (int)(i % 8); const int r = (int)(i / 8); const int L = seqlen(r), pos = r & (L - 1), kvh = h >> 2;
        float q[64], o[64];
        const bf16* qp = P + (size_t)r * NIN + h * 64;
#pragma unroll
        for (int d = 0; d < 64; ++d) { q[d] = bf2f(qp[d]) * 0.125f; o[d] = 0.f; }
        float m = p.sink[h], l = 1.0f;
        const int k0 = pos - 128 < 0 ? 0 : pos - 128, k1 = pos + 128 > L - 1 ? L - 1 : pos + 128;
        for (int kp = k0; kp <= k1; ++kp) {
            const bf16* kr = P + (size_t)(r + kp - pos) * NIN + OK_ + kvh * 64; const bf16* vr = P + (size_t)(r + kp - pos) * NIN + OV + kvh * 64;
            float s = 0.f;
#pragma unroll
            for (int d = 0; d < 64; ++d) s += q[d] * bf2f(kr[d]);
            const float mn = fmaxf(m, s), a = __expf(m - mn), e = __expf(s - mn);
            l = l * a + e; m = mn;
#pragma unroll
            for (int d = 0; d < 64; ++d) o[d] = o[d] * a + e * bf2f(vr[d]);
        }
        const float il = 1.0f / l; float* op = AT + (size_t)r * 512 + h * 64;
#pragma unroll
        for (int d = 0; d < 64; ++d) op[d] = o[d] * il;
    }
}
__device__ __forceinline__ void phase_gmlp_stats(const Params& p) {
    const bf16* P = (const bf16*)(p.ws + WS_R1); float* ST = (float*)(p.ws + WS_ST);
    const int lane = threadIdx.x & 63, gw = blockIdx.x * 8 + (threadIdx.x >> 6), NGW = gridDim.x * 8;
    for (int r = gw; r < TT; r += NGW) {
        const bf16* v = P + (size_t)r * NIN + OVG; float x[8]; float s = 0.f;
#pragma unroll
        for (int j = 0; j < 8; ++j) { x[j] = bf2f(v[lane + 64 * j]); s += x[j]; }
        const float mu = wave_sum(s) * (1.f / 512.f); float q = 0.f;
#pragma unroll
        for (int j = 0; j < 8; ++j) { const float d = x[j] - mu; q += d * d; }
        const float rstd = 1.f / sqrtf(wave_sum(q) * (1.f / 512.f) + EPS);
        if (lane == 0) { ST[2 * r] = mu; ST[2 * r + 1] = rstd; }
    }
}
__device__ __forceinline__ void phase_gmlp_naive(const Params& p) {
    const bf16* P = (const bf16*)(p.ws + WS_R1); const float* ST = (const float*)(p.ws + WS_ST); float* GM = (float*)(p.ws + WS_R3);
    const size_t gt = (size_t)blockIdx.x * NTHR + threadIdx.x, NGT = (size_t)gridDim.x * NTHR;
    for (size_t idx = gt; idx < (size_t)TT * 512; idx += NGT) {
        const int c = (int)(idx & 511), r = (int)(idx >> 9), i = r & 127, rb = r - i, g = c >> 6;
        const float lg = p.ln_g[c], lb = p.ln_b[c]; const float* w = p.w_s + ((size_t)g * 128 + i) * 128;
        float s = 0.f;
        for (int j = 0; j < 128; ++j) { const float vv = bf2f(P[(size_t)(rb + j) * NIN + OVG + c]); s += w[j] * ((vv - ST[2 * (rb + j)]) * ST[2 * (rb + j) + 1] * lg + lb); }
        GM[idx] = bf2f(P[(size_t)r * NIN + OU + c]) * (s + p.b_s[g * 128 + i]);
    }
}
__device__ __forceinline__ void phase_mixnorm(const Params& p) {
    const float* AT = (const float*)(p.ws + WS_R2); const float* GM = (const float*)(p.ws + WS_R3); bf16* MIX = (bf16*)(p.ws + WS_R0);
    const int lane = threadIdx.x & 63, gw = blockIdx.x * 8 + (threadIdx.x >> 6), NGW = gridDim.x * 8;
    for (int r = gw; r < TT; r += NGW) {
#pragma unroll
        for (int part = 0; part < 2; ++part) {
            const float* src = (part ? GM : AT) + (size_t)r * 512; const float* g = part ? p.g_gmlp : p.g_attn;
            float x[8]; float s = 0.f;
#pragma unroll
            for (int j = 0; j < 8; ++j) { x[j] = src[lane + 64 * j]; s += x[j] * x[j]; }
            const float rstd = 1.f / sqrtf(wave_sum(s) * (1.f / 512.f) + EPS);
#pragma unroll
            for (int j = 0; j < 8; ++j) MIX[(size_t)r * DM + part * 512 + lane + 64 * j] = (bf16)f2bf(x[j] * rstd * g[lane + 64 * j]);
        }
    }
}

typedef float f32x16 __attribute__((ext_vector_type(16)));
constexpr float LOG2E = 1.4426950408889634f, C_SCALE = 0.125f * LOG2E;
constexpr int KPITCH = 144, VPITCH = 776, LDS_KO = 0, LDS_VT = 384 * KPITCH  , VNPITCH = 260, LDS_SSQ = 133120, LDS_RSTD = LDS_SSQ + 4096;
static_assert(LDS_VT + 64 * VPITCH <= LDS_SSQ && 512 * VNPITCH <= LDS_SSQ, "mixer LDS map");
__device__ __forceinline__ int crow16(int r, int h) { return (r & 3) + 8 * (r >> 2) + 4 * h; }
__device__ __forceinline__ void mix_normalize(bf16* MIXblk, const float* gain, LAS unsigned char* lds, int tid) {
    LAS float* ssq = (LAS float*)(lds + LDS_SSQ); LAS float* rstd = (LAS float*)(lds + LDS_RSTD);
    __syncthreads();
    if (tid < 128) { float s = 0.f;
#pragma unroll
        for (int hd = 0; hd < 8; ++hd) s += ssq[hd * 128 + tid];
        rstd[tid] = 1.f / sqrtf(s * (1.f / 512.f) + EPS); }
    __syncthreads();
#pragma unroll 4
    for (int i = 0; i < 16; ++i) { const int idx = tid + 512 * i, row = idx >> 6, ch = idx & 63;
        u32x4* ptr = (u32x4*)(MIXblk + (size_t)row * DM + ch * 8); const u32x4 v = *ptr; const float rs = rstd[row];
        const f32x4 g0 = *(const f32x4*)(gain + ch * 8), g1 = *(const f32x4*)(gain + ch * 8 + 4);
        u32x4 o;
        o.x = pk2(__uint_as_float(v.x << 16) * rs * g0.x, __uint_as_float(v.x & 0xffff0000u) * rs * g0.y);
        o.y = pk2(__uint_as_float(v.y << 16) * rs * g0.z, __uint_as_float(v.y & 0xffff0000u) * rs * g0.w);
        o.z = pk2(__uint_as_float(v.z << 16) * rs * g1.x, __uint_as_float(v.z & 0xffff0000u) * rs * g1.y);
        o.w = pk2(__uint_as_float(v.w << 16) * rs * g1.z, __uint_as_float(v.w & 0xffff0000u) * rs * g1.w);
        *ptr = o; }
}
__device__ __forceinline__ void attn_unit(const Params& p, LAS unsigned char* lds, int blk) {
    const int tid = threadIdx.x, lane = tid & 63, w = __builtin_amdgcn_readfirstlane(tid >> 6), r32 = lane & 31, h = lane >> 5;
    const int rb = blk * 128, L = seqlen(rb), pos0 = rb & (L - 1);
    const bool has_lo = pos0 > 0, has_hi = pos0 + 128 < L;
    const bf16* P = (const bf16*)(p.ws + WS_R1); bf16* MIX = (bf16*)(p.ws + WS_R0);
    LAS float* ssq = (LAS float*)(lds + LDS_SSQ);
    for (int kvh = 0; kvh < 2; ++kvh) {
        __syncthreads();
#pragma unroll
        for (int i = 0; i < 6; ++i) { const int idx = tid + 512 * i, key = idx >> 3, ch = idx & 7, b3 = i >> 1;
            if ((b3 == 0 && !has_lo) || (b3 == 2 && !has_hi)) continue;
            const u32x4 v = *(const u32x4*)(P + (size_t)(rb - 128 + key) * NIN + OK_ + kvh * 64 + ch * 8);
            *(LAS u32x4*)(lds + LDS_KO + key * KPITCH + ch * 16) = v; }
#pragma unroll
        for (int i = 0; i < 3; ++i) { const int idx = tid + 512 * i, kp = idx >> 3, ch = idx & 7;
            if ((i == 0 && !has_lo) || (i == 2 && !has_hi)) continue;
            const bf16* src = P + (size_t)(rb - 128 + 2 * kp) * NIN + OV + kvh * 64 + ch * 8;
            const u32x4 a = *(const u32x4*)src, b = *(const u32x4*)(src + NIN);
#pragma unroll
            for (int e = 0; e < 8; ++e) { const unsigned lo = (e & 1) ? (a[e >> 1] >> 16) : (a[e >> 1] & 0xffffu), hi = (e & 1) ? (b[e >> 1] & 0xffff0000u) : (b[e >> 1] << 16);
                *(LAS unsigned*)(lds + LDS_VT + (8 * ch + e) * VPITCH + kp * 4) = lo | hi; } }
        __syncthreads();
        const int head = kvh * 4 + (w >> 1);
        for (int qq = 0; qq < 2; ++qq) {
            const int qb = 2 * (w & 1) + qq;
            const bf16* qp = P + (size_t)(rb + 32 * qb + r32) * NIN + head * 64 + 8 * h;
            bf16x8 qr[4];
#pragma unroll
            for (int d0 = 0; d0 < 4; ++d0) qr[d0] = *(const bf16x8*)(qp + 16 * d0);
            float m = p.sink[head] * LOG2E, l = h == 0 ? 1.f : 0.f;
            f32x16 o0, o1;
#pragma unroll
            for (int r = 0; r < 16; ++r) { o0[r] = 0.f; o1[r] = 0.f; }
            const int kt_lo = has_lo ? qb : (qb > 4 ? qb : 4), kt_hi = has_hi ? qb + 8 : (qb + 8 < 7 ? qb + 8 : 7);
            for (int kt = kt_lo; kt <= kt_hi; ++kt) {
                f32x16 s;
#pragma unroll
                for (int r = 0; r < 16; ++r) s[r] = 0.f;
                const LAS unsigned char* kb = lds + LDS_KO + (32 * kt + r32) * KPITCH + 16 * h;
#pragma unroll
                for (int d0 = 0; d0 < 4; ++d0) { const bf16x8 kf = *(const LAS bf16x8*)(kb + 32 * d0); s = __builtin_amdgcn_mfma_f32_32x32x16_bf16(kf, qr[d0], s, 0, 0, 0); }
                if (kt == qb) {
#pragma unroll
                    for (int r = 0; r < 16; ++r) if (crow16(r, h) < r32) s[r] = -INFINITY;
                }
                if (kt == qb + 8) {
#pragma unroll
                    for (int r = 0; r < 16; ++r) if (crow16(r, h) > r32) s[r] = -INFINITY;
                }
                float tm = s[0];
#pragma unroll
                for (int r = 1; r < 16; ++r) tm = fmaxf(tm, s[r]);
                tm = fmaxf(tm, __shfl_xor(tm, 32));
                const float mn = fmaxf(m, tm * C_SCALE);
                if (__any(mn > m)) { const float al = __builtin_amdgcn_exp2f(m - mn); l *= al;
#pragma unroll
                    for (int r = 0; r < 16; ++r) { o0[r] *= al; o1[r] *= al; }
                    m = mn; }
                float ps = 0.f;
#pragma unroll
                for (int r = 0; r < 16; ++r) { s[r] = __builtin_amdgcn_exp2f(s[r] * C_SCALE - m); ps += s[r]; }
                l += ps;
                u32x4 pw0, pw1;
                pw0.x = pk2(s[0], s[1]); pw0.y = pk2(s[2], s[3]); pw0.z = pk2(s[4], s[5]); pw0.w = pk2(s[6], s[7]);
                pw1.x = pk2(s[8], s[9]); pw1.y = pk2(s[10], s[11]); pw1.z = pk2(s[12], s[13]); pw1.w = pk2(s[14], s[15]);
                const bf16x8 pb0 = __builtin_bit_cast(bf16x8, pw0), pb1 = __builtin_bit_cast(bf16x8, pw1);
                const LAS unsigned char* vb = lds + LDS_VT + r32 * VPITCH + (32 * kt + 4 * h) * 2;
#pragma unroll
                for (int s2 = 0; s2 < 2; ++s2) {
#pragma unroll
                    for (int db = 0; db < 2; ++db) { const LAS unsigned char* vp = vb + db * 32 * VPITCH + s2 * 32;
                        const u32x2 v0 = *(const LAS u32x2*)vp, v1 = *(const LAS u32x2*)(vp + 16);
                        const u32x4 vv = (u32x4){v0.x, v0.y, v1.x, v1.y}; const bf16x8 vf = __builtin_bit_cast(bf16x8, vv);
                        if (db == 0) o0 = __builtin_amdgcn_mfma_f32_32x32x16_bf16(vf, s2 ? pb1 : pb0, o0, 0, 0, 0);
                        else o1 = __builtin_amdgcn_mfma_f32_32x32x16_bf16(vf, s2 ? pb1 : pb0, o1, 0, 0, 0); }
                }
            }
            l += __shfl_xor(l, 32);
            const float inv = 1.f / l; float ss = 0.f;
#pragma unroll
            for (int r = 0; r < 16; ++r) { o0[r] *= inv; o1[r] *= inv; ss += o0[r] * o0[r] + o1[r] * o1[r]; }
            ss += __shfl_xor(ss, 32);
            if (h == 0) ssq[head * 128 + 32 * qb + r32] = ss;
            bf16* op = MIX + (size_t)(rb + 32 * qb + r32) * DM + head * 64 + 4 * h;
#pragma unroll
            for (int g = 0; g < 4; ++g) { u32x2 wv; wv.x = pk2(o0[4 * g], o0[4 * g + 1]); wv.y = pk2(o0[4 * g + 2], o0[4 * g + 3]); *(u32x2*)(op + 8 * g) = wv;
                wv.x = pk2(o1[4 * g], o1[4 * g + 1]); wv.y = pk2(o1[4 * g + 2], o1[4 * g + 3]); *(u32x2*)(op + 32 + 8 * g) = wv; }
        }
    }
    mix_normalize(MIX + (size_t)rb * DM, p.g_attn, lds, tid);
}
__device__ __forceinline__ void gmlp_unit(const Params& p, LAS unsigned char* lds, int blk) {
    const int tid = threadIdx.x, lane = tid & 63, w = __builtin_amdgcn_readfirstlane(tid >> 6), r32 = lane & 31, h = lane >> 5;
    const int rb = blk * 128;
    const bf16* P = (const bf16*)(p.ws + WS_R1); bf16* MIX = (bf16*)(p.ws + WS_R0); const bf16* WsB = (const bf16*)(p.ws + WS_WS);
    LAS float* ssq = (LAS float*)(lds + LDS_SSQ);
    __syncthreads();
    for (int pr = 0; pr < 8; ++pr) { const int j0 = 16 * w + 2 * pr; const bf16* va = P + (size_t)(rb + j0) * NIN + OVG + lane; const bf16* vb = va + NIN;
        float a[8], b[8]; float sa = 0.f, sb = 0.f;
#pragma unroll
        for (int e = 0; e < 8; ++e) { a[e] = bf2f(va[64 * e]); b[e] = bf2f(vb[64 * e]); sa += a[e]; sb += b[e]; }
        const float ma = wave_sum(sa) * (1.f / 512.f), mb = wave_sum(sb) * (1.f / 512.f); float qa = 0.f, qb_ = 0.f;
#pragma unroll
        for (int e = 0; e < 8; ++e) { a[e] -= ma; b[e] -= mb; qa += a[e] * a[e]; qb_ += b[e] * b[e]; }
        const float ra = 1.f / sqrtf(wave_sum(qa) * (1.f / 512.f) + EPS), rbs = 1.f / sqrtf(wave_sum(qb_) * (1.f / 512.f) + EPS);
#pragma unroll
        for (int e = 0; e < 8; ++e) { const int c = lane + 64 * e; const float lg = p.ln_g[c], lb = p.ln_b[c];
            *(LAS unsigned*)(lds + c * VNPITCH + j0 * 2) = pk2(a[e] * ra * lg + lb, b[e] * rbs * lg + lb); }
    }
    __syncthreads();
    const int g = w;
    for (int ib = 0; ib < 4; ++ib) {
        bf16x8 bfr[8];
#pragma unroll
        for (int ks = 0; ks < 8; ++ks) bfr[ks] = *(const bf16x8*)(WsB + ((size_t)g * 128 + 32 * ib + r32) * 128 + 16 * ks + 8 * h);
        const int row = rb + 32 * ib + r32; const float bsv = p.b_s[g * 128 + 32 * ib + r32]; float ss = 0.f;
#pragma unroll
        for (int db = 0; db < 2; ++db) {
            f32x16 acc;
#pragma unroll
            for (int r = 0; r < 16; ++r) acc[r] = 0.f;
#pragma unroll
            for (int ks = 0; ks < 8; ++ks) { const LAS unsigned* ap = (const LAS unsigned*)(lds + (64 * g + 32 * db + r32) * VNPITCH + (16 * ks + 8 * h) * 2);
                const u32x4 av = (u32x4){ap[0], ap[1], ap[2], ap[3]}; acc = __builtin_amdgcn_mfma_f32_32x32x16_bf16(__builtin_bit_cast(bf16x8, av), bfr[ks], acc, 0, 0, 0); }
            const bf16* up = P + (size_t)row * NIN + OU + 64 * g + 32 * db + 4 * h; bf16* op = MIX + (size_t)row * DM + 512 + 64 * g + 32 * db + 4 * h;
#pragma unroll
            for (int gq = 0; gq < 4; ++gq) { const u32x2 uu = *(const u32x2*)(up + 8 * gq);
                const float o0 = __uint_as_float(uu.x << 16) * (acc[4 * gq] + bsv), o1 = __uint_as_float(uu.x & 0xffff0000u) * (acc[4 * gq + 1] + bsv);
                const float o2 = __uint_as_float(uu.y << 16) * (acc[4 * gq + 2] + bsv), o3 = __uint_as_float(uu.y & 0xffff0000u) * (acc[4 * gq + 3] + bsv);
                ss += (o0 * o0 + o1 * o1) + (o2 * o2 + o3 * o3);
                u32x2 wv; wv.x = pk2(o0, o1); wv.y = pk2(o2, o3); *(u32x2*)(op + 8 * gq) = wv; }
        }
        ss += __shfl_xor(ss, 32);
        if (h == 0) ssq[g * 128 + 32 * ib + r32] = ss;
    }
    mix_normalize(MIX + (size_t)rb * DM + 512, p.g_gmlp, lds, tid);
}
__device__ __forceinline__ void phase_mixer(const Params& p, LAS unsigned char* lds) {
    for (int u = blockIdx.x; u < TT / 128; u += gridDim.x) attn_unit(p, lds, u);
    for (int u = blockIdx.x; u < TT / 128; u += gridDim.x) gmlp_unit(p, lds, u);
    __syncthreads();
}
__device__ __forceinline__ void phase_r3(const Params& p) {
    const bf16* M = (const bf16*)(p.ws + WS_R1); bf16* H2 = (bf16*)(p.ws + WS_R0);
    const int lane = threadIdx.x & 63, gw = blockIdx.x * 8 + (threadIdx.x >> 6), NGW = gridDim.x * 8;
    for (int r = gw; r < TT; r += NGW) {
        const f32x4* xr = (const f32x4*)xrow(p, r) + lane; const u32x2* mr = (const u32x2*)(M + (size_t)r * DM) + lane;
        f32x4 mv[4], xv[4]; float s = 0.f;
#pragma unroll
        for (int j = 0; j < 4; ++j) { const u32x2 w = mr[64 * j]; mv[j] = (f32x4){__uint_as_float(w.x << 16), __uint_as_float(w.x & 0xffff0000u), __uint_as_float(w.y << 16), __uint_as_float(w.y & 0xffff0000u)};
            xv[j] = xr[64 * j]; s += (mv[j].x * mv[j].x + mv[j].y * mv[j].y) + (mv[j].z * mv[j].z + mv[j].w * mv[j].w); }
        const float rstd = 1.f / sqrtf(wave_sum(s) * (1.f / DM) + EPS); float s2 = 0.f;
        f32x4* orow = (f32x4*)(p.out + (size_t)r * DM) + lane;
#pragma unroll
        for (int j = 0; j < 4; ++j) { const f32x4 g = ((const f32x4*)p.g_mix_post)[lane + 64 * j]; xv[j] = xv[j] + mv[j] * rstd * g; orow[64 * j] = xv[j];
            s2 += (xv[j].x * xv[j].x + xv[j].y * xv[j].y) + (xv[j].z * xv[j].z + xv[j].w * xv[j].w); }
        const float rstd2 = 1.f / sqrtf(wave_sum(s2) * (1.f / DM) + EPS);
        u32x2* o8 = (u32x2*)(H2 + (size_t)r * DM) + lane;
#pragma unroll
        for (int j = 0; j < 4; ++j) { const f32x4 g = ((const f32x4*)p.g_ffn_pre)[lane + 64 * j]; u32x2 w; w.x = pk2(xv[j].x * rstd2 * g.x, xv[j].y * rstd2 * g.y); w.y = pk2(xv[j].z * rstd2 * g.z, xv[j].w * rstd2 * g.w); o8[64 * j] = w; }
    }
}
constexpr int ZCH = 16384;
__device__ __forceinline__ void phase_conv_naive(const Params& p, int chunk) {
    const bf16* Z = (const bf16*)(p.ws + WS_R1); bf16* F = (bf16*)(p.ws + WS_F);
    const size_t gt = (size_t)blockIdx.x * NTHR + threadIdx.x, NGT = (size_t)gridDim.x * NTHR;
    for (size_t idx = gt; idx < (size_t)ZCH * DFF; idx += NGT) {
        const int c = (int)(idx % DFF), lr = (int)(idx / DFF), r = chunk * ZCH + lr; const int L = seqlen(r), pos = r & (L - 1);
        const int cg_ = (c >> 7) * 256 + (c & 127), cu = cg_ + 128;
        const bf16* z = Z + (size_t)lr * NF1;
        const bool hl = pos > 0, hr = pos < L - 1;
        const float g0 = hl ? bf2f(z[cg_ - NF1]) : 0.f, g1 = bf2f(z[cg_]), g2 = hr ? bf2f(z[cg_ + NF1]) : 0.f;
        const float u0 = hl ? bf2f(z[cu - NF1]) : 0.f, u1 = bf2f(z[cu]), u2 = hr ? bf2f(z[cu + NF1]) : 0.f;
        const float* cw = p.conv_w;
        const float gg = g0 * cw[c] + g1 * cw[NF1 + c] + g2 * cw[2 * NF1 + c] + p.conv_b[c];
        const float uu = u0 * cw[DFF + c] + u1 * cw[NF1 + DFF + c] + u2 * cw[2 * NF1 + DFF + c] + p.conv_b[DFF + c];
        const float sl = gg / (1.0f + __expf(-gg));
        F[(size_t)r * DFF + c] = (bf16)f2bf(sl * uu);
    }
}
__device__ __forceinline__ void phase_r6(const Params& p) {
    const bf16* Y = (const bf16*)(p.ws + WS_R0);
    const int lane = threadIdx.x & 63, gw = blockIdx.x * 8 + (threadIdx.x >> 6), NGW = gridDim.x * 8;
    for (int r = gw; r < TT; r += NGW) {
        const u32x2* mr = (const u32x2*)(Y + (size_t)r * DM) + lane; f32x4* orow = (f32x4*)(p.out + (size_t)r * DM) + lane;
        f32x4 mv[4], xv[4]; float s = 0.f;
#pragma unroll
        for (int j = 0; j < 4; ++j) { const u32x2 w = mr[64 * j]; mv[j] = (f32x4){__uint_as_float(w.x << 16), __uint_as_float(w.x & 0xffff0000u), __uint_as_float(w.y << 16), __uint_as_float(w.y & 0xffff0000u)};
            xv[j] = orow[64 * j]; s += (mv[j].x * mv[j].x + mv[j].y * mv[j].y) + (mv[j].z * mv[j].z + mv[j].w * mv[j].w); }
        const float rstd = 1.f / sqrtf(wave_sum(s) * (1.f / DM) + EPS);
#pragma unroll
        for (int j = 0; j < 4; ++j) { const f32x4 g = ((const f32x4*)p.g_ffn_post)[lane + 64 * j]; orow[64 * j] = xv[j] + mv[j] * rstd * g; }
    }
}

constexpr int LDS_BYTES = 147456;
template <class Epi>
__device__ __forceinline__ void run_gemm(LAS unsigned char* lds, const bf16* A, const bf16* Bt, int M, int N, int K, const Epi& E) {
    pg8::Gemm g{A, Bt, M, N, K}; pg8::StaticOrder S; S.init(M, N, (int)gridDim.x, (int)blockIdx.x);
    pg8::gemm_phase<Epi, pg8::StaticOrder, true, true>(lds, g, S, E);
}
constexpr int NPHASE = 22;
__global__ void __launch_bounds__(NTHR, 2) mega_fwd(Params p) {
    extern __shared__ __attribute__((aligned(16))) unsigned char lds_raw[];
    LAS unsigned char* lds = (LAS unsigned char*)lds_raw;
    cg::grid_group grid = cg::this_grid();
    unsigned char* ws = p.ws;
    const int lo = p.ph_lo, hi = p.ph_hi;
#define IN(k) (lo <= (k) && (k) < hi)
#define SEAM(k) do { if (IN(k) && IN((k) + 1)) grid.sync(); } while (0)
    if (IN(0)) phase_prologue(p, lds);
    SEAM(0);
    if (IN(1)) { pg8::EpiBf16<0> E{(bf16*)(ws + WS_R1), NIN, nullptr, 0, 0, 1.f}; run_gemm(lds, (const bf16*)(ws + WS_R0), (const bf16*)(ws + WS_WIN), TT, NIN, DM, E); }
    SEAM(1);
    if (IN(2)) phase_e1(p);
    SEAM(2);
#if defined(MIXER_NAIVE)
    if (IN(3)) { phase_attn_naive(p); phase_gmlp_stats(p); }
    SEAM(3);
    if (IN(4)) phase_gmlp_naive(p);
    SEAM(4);
    if (IN(5)) phase_mixnorm(p);
    SEAM(5);
#else
    if (IN(3)) phase_mixer(p, lds);
    if (IN(3) && IN(6)) grid.sync();
#endif
    if (IN(6)) { pg8::EpiBf16<0> E{(bf16*)(ws + WS_R1), DM, nullptr, 0, 0, 1.f}; run_gemm(lds, (const bf16*)(ws + WS_R0), (const bf16*)(ws + WS_WO), TT, DM, DM, E); }
    SEAM(6);
    if (IN(7)) phase_r3(p);
    SEAM(7);
#if defined(CONV_NAIVE)
    for (int c = 0; c < 6; ++c) {
        if (IN(8 + 2 * c)) { pg8::EpiBf16<0> E{(bf16*)(ws + WS_R1), NF1, nullptr, 0, 0, 1.f}; run_gemm(lds, (const bf16*)(ws + WS_R0) + (size_t)c * ZCH * DM, (const bf16*)(ws + WS_WF1), ZCH, NF1, DM, E); }
        SEAM(8 + 2 * c);
        if (IN(9 + 2 * c)) phase_conv_naive(p, c);
        SEAM(9 + 2 * c);
    }
#else
    if (IN(8)) { pg8::EpiConvSilu E{(bf16*)(ws + WS_F), p.conv_w, p.conv_b, DFF, TT, T1};
        pg8::Gemm g{(const bf16*)(ws + WS_R0) - DM, (const bf16*)(ws + WS_WF1), 391 * 256, NF1, DM, 126, 64, 252};
        pg8::StaticOrder S; S.init(391 * 256, NF1, (int)gridDim.x, (int)blockIdx.x);
        pg8::gemm_phase<pg8::EpiConvSilu, pg8::StaticOrder, true, true>(lds, g, S, E); }
    if (IN(8) && IN(20)) grid.sync();
#endif
    if (IN(20)) { pg8::EpiBf16<0> E{(bf16*)(ws + WS_R0), DM, nullptr, 0, 0, 1.f}; run_gemm(lds, (const bf16*)(ws + WS_F), (const bf16*)(ws + WS_WF2), TT, DM, DFF, E); }
    SEAM(20);
    if (IN(21)) phase_r6(p);
}

extern "C" void kernel_launch(void* const* d_in, const int* in_sizes, int n_in, void* d_out, int out_size, void* d_ws, size_t ws_size, hipStream_t stream) {
    static int grid = 0;
    if (grid == 0) {
        if (n_in != 19 || out_size != TT * DM || ws_size < WS_END) { fprintf(stderr, "kernel_launch: unexpected shapes n_in %d out %d ws %zu\n", n_in, out_size, ws_size); grid = -1; return; }
        int dev = 0, cus = 0, per_cu = 0;
        (void)hipGetDevice(&dev); (void)hipDeviceGetAttribute(&cus, hipDeviceAttributeMultiprocessorCount, dev);
        if (hipFuncSetAttribute((const void*)mega_fwd, hipFuncAttributeMaxDynamicSharedMemorySize, LDS_BYTES) != hipSuccess) { fprintf(stderr, "hipFuncSetAttribute failed\n"); grid = -1; return; }
        if (hipOccupancyMaxActiveBlocksPerMultiprocessor(&per_cu, (const void*)mega_fwd, NTHR, LDS_BYTES) != hipSuccess || per_cu < 1) { fprintf(stderr, "occupancy query: %d\n", per_cu); per_cu = 1; }
        (void)hipGetLastError();
        grid = cus * 1;
    }
    if (grid < 0) return;
    Params p{};
    p.xp = (const float*)d_in[0]; p.xs = (const float*)d_in[1]; p.g_mix_pre = (const float*)d_in[2]; p.w_in = (const float*)d_in[3]; p.sink = (const float*)d_in[4];
    p.ln_g = (const float*)d_in[5]; p.ln_b = (const float*)d_in[6]; p.w_s = (const float*)d_in[7]; p.b_s = (const float*)d_in[8]; p.g_attn = (const float*)d_in[9];
    p.g_gmlp = (const float*)d_in[10]; p.w_o = (const float*)d_in[11]; p.g_mix_post = (const float*)d_in[12]; p.g_ffn_pre = (const float*)d_in[13]; p.w_f1 = (const float*)d_in[14];
    p.conv_w = (const float*)d_in[15]; p.conv_b = (const float*)d_in[16]; p.w_f2 = (const float*)d_in[17]; p.g_ffn_post = (const float*)d_in[18];
    p.out = (float*)d_out; p.ws = (unsigned char*)d_ws;
#if defined(MULTI_LAUNCH)
    for (int ph = 0; ph < NPHASE; ++ph) { p.ph_lo = ph; p.ph_hi = ph + 1; hipLaunchKernelGGL(mega_fwd, dim3(grid), dim3(NTHR), LDS_BYTES, stream, p); }
#else
    p.ph_lo = 0; p.ph_hi = NPHASE;
    void* args[] = {&p};
    hipError_t e = hipLaunchCooperativeKernel((const void*)mega_fwd, dim3(grid), dim3(NTHR), args, LDS_BYTES, stream);
    if (e != hipSuccess) fprintf(stderr, "cooperative launch failed: %s (grid %d)\n", hipGetErrorString(e), grid);
#endif
}
```

```cpp
#include <hip/hip_runtime.h>
#include <hip/hip_cooperative_groups.h>
#include <cstdio>
#include <cstdint>
namespace cg = cooperative_groups;
#ifndef PROBE_MASK
#define PROBE_MASK 0
#endif
namespace pg8 {
#define PG8_LAS __attribute__((address_space(3)))
typedef unsigned short bf16_t;
typedef short bf16x8 __attribute__((ext_vector_type(8)));
typedef float f32x4 __attribute__((ext_vector_type(4)));
typedef unsigned u32x4 __attribute__((ext_vector_type(4)));
constexpr int BM = 256, BK = 64, HALF = 128, HTB = HALF * BK * 2  , STAGE_BYTES = 8 * HTB, NXCD = 8, WGM = 8;

__host__ __device__ __forceinline__ int lds_byte(int r, int c) { const int st = (r >> 4) * 2 + (c >> 5), rr = r & 15, cc = c & 31, ob = rr * 64 + cc * 2; return st * 1024 + (ob ^ (((ob >> 9) & 1) << 5)); }
__host__ __device__ __forceinline__ void stage_rc(int b, int& R, int& C) { const int st = b / 1024, sb = b % 1024, swz = sb ^ (((sb >> 9) & 1) << 5); R = (st >> 1) * 16 + swz / 64; C = (st & 1) * 32 + (swz % 64) / 2; }
__host__ __device__ __forceinline__ int perm32(int rho) { const int n = rho >> 4, i = rho & 15; return 8 * (i >> 2) + 4 * n + (i & 3); }

struct Unit { int pm, pn; };
struct Gemm { const bf16_t* A; const bf16_t* Bt; int M, N, K; int a_wrs = 64, a_hrows = 128, a_trows = 256, a_mode = 0;
    __device__ __forceinline__ int arow(int R) const { return a_mode == 0 ? (R >> 6) * a_wrs + (R & 63) : (R >> 6) * a_wrs + (R & 15) * 8 + ((R >> 4) & 3); } };

struct StaticOrder {
    int nM, nN, nwg, G, c;
    __host__ __device__ void init(int M, int N, int G_, int c_) { nM = M / BM; nN = N / BM; nwg = nM * nN; G = G_; c = c_; }
    __host__ __device__ bool next(int i, Unit& u) const {
        const long L = (long)i * G + c; if (L >= nwg) return false;
        int wgid = (int)L; { const int q = nwg / NXCD, r = nwg % NXCD, xcd = wgid % NXCD, off = wgid / NXCD; wgid = (xcd < r ? xcd * (q + 1) : r * (q + 1) + (xcd - r) * q) + off; }
        const int nig = WGM * nN, gid = wgid / nig, fm = gid * WGM, gsz = (nM - fm) < WGM ? (nM - fm) : WGM;
        u.pm = fm + ((wgid % nig) % gsz); u.pn = (wgid % nig) / gsz; return true;
    }
    __device__ __forceinline__ void a_ready(const Unit&) const {}
    __device__ __forceinline__ void done(const Unit&) const {}
};

__device__ __forceinline__ unsigned cvt_pk_bf16(float lo, float hi) { unsigned r; asm volatile("v_cvt_pk_bf16_f32 %0, %1, %2" : "=v"(r) : "v"(lo), "v"(hi)); return r; }
typedef float f32x2 __attribute__((ext_vector_type(2)));
__device__ __forceinline__ f32x2 gelu_pk(f32x2 v) {
    const f32x2 av = __builtin_elementwise_abs(v), d = av * 0.2316418882f + 1.0f;
    f32x2 t; t.x = __builtin_amdgcn_rcpf(d.x); t.y = __builtin_amdgcn_rcpf(d.y);
    f32x2 q = t * 0.5307027145f + (-0.7265760135f); q = q * t + 0.7107068705f; q = q * t + (-0.142248368f); q = q * t + 0.127414796f; q = q * t;
    const f32x2 s = (v * v) * (-0.72134752044f);
    f32x2 e; e.x = __builtin_amdgcn_exp2f(s.x); e.y = __builtin_amdgcn_exp2f(s.y);
    const f32x2 m = v * (q * e), r = v - m;
    f32x2 o; o.x = v.x < 0.f ? m.x : r.x; o.y = v.y < 0.f ? m.y : r.y; return o;
}

template <int ACT  > struct EpiBf16 {
    static constexpr bool PERM = true, AFTER_DRAIN = false; static_assert(ACT == 0 || ACT == 1, "EpiBf16: ACT is 0 (none) or 1 (gelu_pk)");
    bf16_t* O; int ldc; const float* bias; int split_cols; size_t split_stride; float scale0;
    __device__ __forceinline__ void operator()(const f32x4 (&acc)[2][2][4][2], const Unit& u, int wr, int wc, int fr, int fq) const {
        const int row0 = u.pm * BM + wr * 64 + fr; int colt = u.pn * BM; bf16_t* base = O;
        float sc = 1.f; if (split_cols) { const int t = colt / split_cols; base += (size_t)t * split_stride; colt -= t * split_cols; if (t == 0) sc = scale0; }
        const int col0 = colt + wc * 32 + 8 * fq, bcol0 = u.pn * BM + wc * 32 + 8 * fq;
        f32x4 bv[2][2];
#pragma unroll
        for (int bj = 0; bj < 2; ++bj)
#pragma unroll
            for (int n = 0; n < 2; ++n) bv[bj][n] = bias ? *(const f32x4*)(bias + bcol0 + bj * HALF + 4 * n) : (f32x4){0.f, 0.f, 0.f, 0.f};
#pragma unroll
        for (int ai = 0; ai < 2; ++ai)
#pragma unroll
            for (int m = 0; m < 4; ++m) { bf16_t* rowp = base + (size_t)(row0 + ai * HALF + m * 16) * ldc + col0;
#pragma unroll
                for (int bj = 0; bj < 2; ++bj) { f32x4 v0 = acc[ai][bj][m][0] + bv[bj][0], v1 = acc[ai][bj][m][1] + bv[bj][1];
                    if (ACT == 1) { f32x2 a = gelu_pk((f32x2){v0[0], v0[1]}), b = gelu_pk((f32x2){v0[2], v0[3]}), c = gelu_pk((f32x2){v1[0], v1[1]}), d = gelu_pk((f32x2){v1[2], v1[3]});
                        v0 = (f32x4){a.x, a.y, b.x, b.y}; v1 = (f32x4){c.x, c.y, d.x, d.y}; }
                    v0 = v0 * sc; v1 = v1 * sc; u32x4 w; w.x = cvt_pk_bf16(v0[0], v0[1]); w.y = cvt_pk_bf16(v0[2], v0[3]); w.z = cvt_pk_bf16(v1[0], v1[1]); w.w = cvt_pk_bf16(v1[2], v1[3]);
                    *(u32x4*)(rowp + bj * HALF) = w; } }
    }
};
template <class Epi, class Sched, bool ALIGN_EPI = false, bool SP2 = false>
__device__ __forceinline__ void gemm_phase(PG8_LAS unsigned char* lds, const Gemm g, const Sched& S, const Epi& E) {
    const int tid = threadIdx.x, wid = __builtin_amdgcn_readfirstlane(tid >> 6), lane = tid & 63, wr = wid >> 2, wc = wid & 3, fr = lane & 15, fq = lane >> 4;
    const int K = g.K, nt = K / BK;
    unsigned voffA[2], voffB[2];
#pragma unroll
    for (int i = 0; i < 2; ++i) { int R, C; stage_rc(tid * 16 + i * 8192, R, C); const int Rb = Epi::PERM ? ((R & ~31) + perm32(R & 31)) : R;
        voffA[i] = (unsigned)(g.arow(R) * K + C) * 2u; voffB[i] = (unsigned)(Rb * K + C) * 2u; }
    const size_t kstep = (size_t)(BK * 2);
    const size_t hstep = (size_t)HALF * K * 2;
    const size_t tstep = 2 * hstep;
    const size_t hstepA = (size_t)g.a_hrows * K * 2, tstepA = (size_t)g.a_trows * K * 2;
    const unsigned ldsw = (unsigned)wid * 1024u;
    const int aoff = lds_byte(wr * 64 + fr, fq * 8), boff = lds_byte(wc * 32 + fr, fq * 8);
#define PG8_SA(b, h) (((b) * 2 + (h)) * HTB)
#define PG8_SB(b, h) ((4 + (b) * 2 + (h)) * HTB)
#define PG8_STAGE(bufoff, gbase, voff) do { _Pragma("unroll") for (int _i = 0; _i < 2; ++_i) \
        __builtin_amdgcn_global_load_lds((const unsigned*)((const char*)(gbase) + (voff)[_i]), (PG8_LAS unsigned*)(lds + (bufoff) + ldsw + _i * 8192), 16, 0, 0); } while (0)
#define PG8_LDA(dst, b, h) do { _Pragma("unroll") for (int m = 0; m < 4; ++m) _Pragma("unroll") for (int k = 0; k < 2; ++k) dst[m][k] = *(const PG8_LAS bf16x8*)(lds + PG8_SA(b, h) + aoff + m * 2048 + k * 1024); } while (0)
#define PG8_LDB(dst, b, h) do { _Pragma("unroll") for (int n = 0; n < 2; ++n) _Pragma("unroll") for (int k = 0; k < 2; ++k) dst[n][k] = *(const PG8_LAS bf16x8*)(lds + PG8_SB(b, h) + boff + n * 2048 + k * 1024); } while (0)
#define PG8_MMA(ai, bj, At, Bt) do { __builtin_amdgcn_s_setprio(1); _Pragma("unroll") for (int m = 0; m < 4; ++m) _Pragma("unroll") for (int n = 0; n < 2; ++n) _Pragma("unroll") for (int k = 0; k < 2; ++k) \
        acc[ai][bj][m][n] = __builtin_amdgcn_mfma_f32_16x16x32_bf16(Bt[n][k], At[m][k], acc[ai][bj][m][n], 0, 0, 0); __builtin_amdgcn_s_setprio(0); } while (0)
#define PG8_WAIT_V(n) asm volatile("s_waitcnt vmcnt(" #n ")" ::: "memory")
#define PG8_WAIT_L(n) asm volatile("s_waitcnt lgkmcnt(" #n ")" ::: "memory")
#define PG8_BAR __builtin_amdgcn_s_barrier()
#define PG8_SCHED __builtin_amdgcn_sched_barrier(0)
    Unit cur, nxt; int ui = 0;
    if (!S.next(0, cur)) return;
    f32x4 acc[2][2][4][2];
#pragma unroll
    for (int a = 0; a < 2; ++a)
#pragma unroll
        for (int b = 0; b < 2; ++b)
#pragma unroll
            for (int m = 0; m < 4; ++m)
#pragma unroll
                for (int n = 0; n < 2; ++n) acc[a][b][m][n] = (f32x4){0.f, 0.f, 0.f, 0.f};
    bf16x8 At[4][2], B0[2][2], B1[2][2];
    const char* cA = (const char*)g.A + (size_t)cur.pm * tstepA; const char* cB = (const char*)g.Bt + (size_t)cur.pn * tstep;
    S.a_ready(cur);
    if constexpr (SP2) {
        PG8_STAGE(PG8_SB(0, 0), cB, voffB); PG8_STAGE(PG8_SB(0, 1), cB + hstep, voffB); PG8_STAGE(PG8_SA(0, 0), cA, voffA); PG8_STAGE(PG8_SA(0, 1), cA + hstepA, voffA);
        if (wr == 1) PG8_BAR;
        PG8_WAIT_V(2); PG8_BAR;
        PG8_STAGE(PG8_SB(1, 0), cB + kstep, voffB); PG8_STAGE(PG8_SA(1, 0), cA + kstep, voffA); PG8_STAGE(PG8_SB(1, 1), cB + hstep + kstep, voffB);
        PG8_WAIT_V(6); PG8_BAR;
    } else {
        PG8_STAGE(PG8_SB(0, 0), cB, voffB); PG8_STAGE(PG8_SA(0, 0), cA, voffA); PG8_STAGE(PG8_SB(0, 1), cB + hstep, voffB); PG8_STAGE(PG8_SA(0, 1), cA + hstepA, voffA);
        if (wr == 1) PG8_BAR;
        PG8_WAIT_V(4); PG8_BAR;
        PG8_STAGE(PG8_SB(1, 0), cB + kstep, voffB); PG8_STAGE(PG8_SA(1, 0), cA + kstep, voffA); PG8_STAGE(PG8_SB(1, 1), cB + hstep + kstep, voffB);
        PG8_WAIT_V(6); PG8_BAR;
    }
    for (;;) {
        const bool has_next = S.next(ui + 1, nxt);
        const char* nA = has_next ? (const char*)g.A + (size_t)nxt.pm * tstepA : cA; const char* nB = has_next ? (const char*)g.Bt + (size_t)nxt.pn * tstep : cB;
        for (int t = 0; t < nt; t += 2) {
            const bool last = (t == nt - 2);
            const char* a1 = cA + (size_t)(t + 1) * kstep;
            const char* a2 = last ? nA : cA + (size_t)(t + 2) * kstep; const char* b2 = last ? nB : cB + (size_t)(t + 2) * kstep;
            const char* a3 = a2 + kstep; const char* b3 = b2 + kstep;
            if (last && has_next) S.a_ready(nxt);
            if constexpr (SP2) {
            PG8_LDB(B0, 0, 0); PG8_LDB(B1, 0, 1); PG8_SCHED; PG8_LDA(At, 0, 0); PG8_STAGE(PG8_SA(1, 1), a1 + hstepA, voffA);
            PG8_WAIT_V(8); PG8_WAIT_L(0); PG8_BAR; PG8_MMA(0, 0, At, B0); PG8_MMA(0, 1, At, B1); PG8_BAR; PG8_SCHED;
            PG8_LDA(At, 0, 1); PG8_STAGE(PG8_SB(0, 0), b2, voffB); PG8_STAGE(PG8_SB(0, 1), b2 + hstep, voffB); PG8_STAGE(PG8_SA(0, 0), a2, voffA);
            PG8_WAIT_V(8); PG8_WAIT_L(0); PG8_BAR; PG8_MMA(1, 0, At, B0); PG8_MMA(1, 1, At, B1); PG8_BAR; PG8_SCHED;
            PG8_LDB(B0, 1, 0); PG8_LDB(B1, 1, 1); PG8_SCHED; PG8_LDA(At, 1, 0); PG8_STAGE(PG8_SA(0, 1), a2 + hstepA, voffA);
            PG8_WAIT_V(8); PG8_WAIT_L(0); PG8_BAR; PG8_MMA(0, 0, At, B0); PG8_MMA(0, 1, At, B1); PG8_BAR; PG8_SCHED;
            PG8_LDA(At, 1, 1); PG8_STAGE(PG8_SB(1, 0), b3, voffB); PG8_STAGE(PG8_SB(1, 1), b3 + hstep, voffB); PG8_STAGE(PG8_SA(1, 0), a3, voffA);
            PG8_WAIT_V(8); PG8_WAIT_L(0); PG8_BAR; PG8_MMA(1, 0, At, B0); PG8_MMA(1, 1, At, B1); PG8_BAR; PG8_SCHED;
            } else {
            PG8_LDB(B0, 0, 0); PG8_SCHED; PG8_LDA(At, 0, 0); PG8_STAGE(PG8_SA(1, 1), a1 + hstepA, voffA);
            PG8_WAIT_L(8); PG8_BAR; PG8_WAIT_L(0); PG8_MMA(0, 0, At, B0); PG8_BAR; PG8_SCHED;
            PG8_LDB(B1, 0, 1); PG8_STAGE(PG8_SB(0, 0), b2, voffB);
            PG8_BAR; PG8_WAIT_L(0); PG8_MMA(0, 1, At, B1); PG8_BAR;
            PG8_LDA(At, 0, 1); PG8_STAGE(PG8_SA(0, 0), a2, voffA);
            PG8_BAR; PG8_WAIT_L(0); PG8_MMA(1, 0, At, B0); PG8_BAR; PG8_SCHED;
            PG8_STAGE(PG8_SB(0, 1), b2 + hstep, voffB);
            PG8_WAIT_V(6); PG8_BAR; PG8_MMA(1, 1, At, B1); PG8_BAR;
            PG8_LDB(B0, 1, 0); PG8_SCHED; PG8_LDA(At, 1, 0); PG8_STAGE(PG8_SA(0, 1), a2 + hstepA, voffA);
            PG8_WAIT_L(8); PG8_BAR; PG8_WAIT_L(0); PG8_MMA(0, 0, At, B0); PG8_BAR; PG8_SCHED;
            PG8_LDB(B1, 1, 1); PG8_STAGE(PG8_SB(1, 0), b3, voffB);
            PG8_BAR; PG8_WAIT_L(0); PG8_MMA(0, 1, At, B1); PG8_BAR;
            PG8_LDA(At, 1, 1); PG8_STAGE(PG8_SA(1, 0), a3, voffA);
            PG8_BAR; PG8_WAIT_L(0); PG8_MMA(1, 0, At, B0); PG8_BAR; PG8_SCHED;
            PG8_STAGE(PG8_SB(1, 1), b3 + hstep, voffB);
            PG8_WAIT_V(6); PG8_BAR; PG8_MMA(1, 1, At, B1); PG8_BAR;
            }
        }
        if constexpr (ALIGN_EPI) { if (wr == 0) PG8_BAR; }
        if constexpr (!Epi::AFTER_DRAIN) { E(acc, cur, wr, wc, fr, fq); S.done(cur); }
        if (!has_next) break;
#pragma unroll
        for (int a = 0; a < 2; ++a)
#pragma unroll
            for (int b = 0; b < 2; ++b)
#pragma unroll
                for (int m = 0; m < 4; ++m)
#pragma unroll
                    for (int n = 0; n < 2; ++n) acc[a][b][m][n] = (f32x4){0.f, 0.f, 0.f, 0.f};
        cur = nxt; cA = nA; cB = nB; ++ui;
        if constexpr (ALIGN_EPI) { if (wr == 1) PG8_BAR; }
    }
    PG8_WAIT_V(0);
    if constexpr (!ALIGN_EPI) { if (wr == 0) PG8_BAR; }
    PG8_BAR;
    if constexpr (Epi::AFTER_DRAIN) { E.fused(acc, cur, wr, wc, fr, fq, lds, wid, lane); S.done(cur); }
#undef PG8_SA
#undef PG8_SB
#undef PG8_STAGE
#undef PG8_LDA
#undef PG8_LDB
#undef PG8_MMA
#undef PG8_WAIT_V
#undef PG8_WAIT_L
#undef PG8_BAR
#undef PG8_SCHED
}
}

namespace pg8 {
struct EpiInProj {
    static constexpr bool PERM = true, AFTER_DRAIN = false;
    bf16_t* O; int ldc; const float* rope; int t1;
    __device__ __forceinline__ void operator()(const f32x4 (&acc)[2][2][4][2], const Unit& u, int wr, int wc, int fr, int fq) const {
        const int row0 = u.pm * BM + wr * 64 + fr, col0 = u.pn * BM + wc * 32 + 8 * fq;
        const bool gel = u.pn >= 3, ropew = (u.pn < 3) && ((wc & 1) == 0);
#pragma unroll
        for (int ai = 0; ai < 2; ++ai)
#pragma unroll
            for (int m = 0; m < 4; ++m) { const int row = row0 + ai * HALF + m * 16; bf16_t* rowp = O + (size_t)row * ldc + col0;
#pragma unroll
                for (int bj = 0; bj < 2; ++bj) { f32x4 v0 = acc[ai][bj][m][0], v1 = acc[ai][bj][m][1];
                    if (gel) { f32x2 a = gelu_pk((f32x2){v0[0], v0[1]}), b = gelu_pk((f32x2){v0[2], v0[3]}), c = gelu_pk((f32x2){v1[0], v1[1]}), d = gelu_pk((f32x2){v1[2], v1[3]});
                        v0 = (f32x4){a.x, a.y, b.x, b.y}; v1 = (f32x4){c.x, c.y, d.x, d.y}; }
                    else if (ropew && !(u.pn == 2 && bj == 1)) {
                        const int pos = row & ((row < t1 ? 8192 : 4096) - 1); const f32x4* rp = (const f32x4*)(rope + (size_t)pos * 16);
                        const f32x4 r0 = rp[0], r1 = rp[1], r2 = rp[2], r3 = rp[3];
                        f32x4 p0, p1;
#pragma unroll
                        for (int e = 0; e < 4; ++e) { p0[e] = __shfl_xor(v0[e], 16); p1[e] = __shfl_xor(v1[e], 16); }
                        if (fq < 2) { const float sg = fq == 0 ? -1.f : 1.f;
                            v0 = (f32x4){v0[0] * r0[0] + sg * p0[0] * r0[1], v0[1] * r0[2] + sg * p0[1] * r0[3], v0[2] * r1[0] + sg * p0[2] * r1[1], v0[3] * r1[2] + sg * p0[3] * r1[3]};
                            v1 = (f32x4){v1[0] * r2[0] + sg * p1[0] * r2[1], v1[1] * r2[2] + sg * p1[1] * r2[3], v1[2] * r3[0] + sg * p1[2] * r3[1], v1[3] * r3[2] + sg * p1[3] * r3[3]}; }
                    }
                    u32x4 w; w.x = cvt_pk_bf16(v0[0], v0[1]); w.y = cvt_pk_bf16(v0[2], v0[3]); w.z = cvt_pk_bf16(v1[0], v1[1]); w.w = cvt_pk_bf16(v1[2], v1[3]);
                    *(u32x4*)(rowp + bj * HALF) = w; } }
    }
};
}

namespace pg8 {
typedef unsigned u32x2 __attribute__((ext_vector_type(2)));
template <int CTRL> __device__ __forceinline__ float dpp0(float v) { return __int_as_float(__builtin_amdgcn_update_dpp(0, __float_as_int(v), CTRL, 0xf, 0xf, true)); }
template <int CTRL> __device__ __forceinline__ f32x4 dpp0v(f32x4 v) { return (f32x4){dpp0<CTRL>(v[0]), dpp0<CTRL>(v[1]), dpp0<CTRL>(v[2]), dpp0<CTRL>(v[3])}; }
struct EpiConvSilu {
    static constexpr bool PERM = true, AFTER_DRAIN = false;
    bf16_t* F; const float* cw; const float* cb; int dff, nrows, t1;
    template <bool MASKED>
    __device__ __forceinline__ void core(const f32x4 (&acc)[2][2][4][2], int t0, int i0, int ch0, int fr) const {
        u32x2 pkd[2][8];
#pragma unroll
        for (int n = 0; n < 2; ++n) {
            f32x4 w0[2], w1[2], w2[2], bb[2], zp[2], zn[2];
#pragma unroll
            for (int bj = 0; bj < 2; ++bj) { const int c = bj * dff + ch0 + 4 * n;
                w0[bj] = *(const f32x4*)(cw + c); w1[bj] = *(const f32x4*)(cw + 2 * dff + c); w2[bj] = *(const f32x4*)(cw + 4 * dff + c); bb[bj] = *(const f32x4*)(cb + c);
                zp[bj] = dpp0v<0x111>(acc[1][bj][3][n]);
                zn[bj] = dpp0v<0x101>(acc[0][bj][0][n]); }
#pragma unroll
            for (int k = 0; k < 8; ++k) {
                f32x4 cvv[2];
#pragma unroll
                for (int bj = 0; bj < 2; ++bj) {
                    const f32x4 z = acc[k >> 2][bj][k & 3][n];
                    f32x4 zl = k == 0 ? zp[bj] : acc[((k + 7) >> 2) & 1][bj][(k + 7) & 3][n];
                    f32x4 zr = k == 7 ? zn[bj] : acc[((k + 1) >> 2) & 1][bj][(k + 1) & 3][n];
                    if (MASKED) { const int i = 8 * fr + k; const float ml = (i == i0) ? 0.f : 1.f, mr = (i == i0 - 1) ? 0.f : 1.f; zl = zl * ml; zr = zr * mr; }
                    cvv[bj] = w0[bj] * zl + (w2[bj] * zr + (w1[bj] * z + bb[bj]));
                }
                const f32x4 gte = cvv[0]; const f32x4 x = gte * (-1.4426950408889634f); f32x4 d;
#pragma unroll
                for (int e = 0; e < 4; ++e) d[e] = __builtin_amdgcn_exp2f(x[e]);
                d = d + 1.0f;
#pragma unroll
                for (int e = 0; e < 4; ++e) d[e] = __builtin_amdgcn_rcpf(d[e]);
                const f32x4 f = (gte * d) * cvv[1];
                pkd[n][k].x = cvt_pk_bf16(f[0], f[1]); pkd[n][k].y = cvt_pk_bf16(f[2], f[3]);
                if (k & 1) __builtin_amdgcn_sched_barrier(0);
            }
        }
#pragma unroll
        for (int k = 0; k < 8; ++k) {
            const u32x4 o = (u32x4){pkd[0][k].x, pkd[0][k].y, pkd[1][k].x, pkd[1][k].y};
            const int i = 8 * fr + k, t = t0 + i;
            const bool ok = (i >= 1) && (i <= 126) && (t < nrows);
            if (ok) *(u32x4*)(F + (size_t)t * dff + ch0) = o;
        }
    }
    __device__ __forceinline__ void operator()(const f32x4 (&acc)[2][2][4][2], const Unit& u, int wr, int wc, int fr, int fq) const {
        const int ch0 = u.pn * 128 + wc * 32 + 8 * fq, t0 = u.pm * 252 - 1 + wr * 126;
        const int s = (t0 + 4096) & ~4095, i0 = s - t0;
        const bool has = (i0 <= 127) && (s <= nrows) && (s >= t1 || (s & 8191) == 0);
        if (has) core<true>(acc, t0, i0, ch0, fr); else core<false>(acc, t0, i0, ch0, fr);
    }
};
}

constexpr int DM = 1024, T1 = 4 * 8192, T2 = 16 * 4096, TT = T1 + T2;
constexpr int L1 = 8192, L2 = 4096;
constexpr int NIN = 1792, DFF = 2816, NF1 = 2 * DFF;
constexpr int OQ = 0, OK_ = 512, OV = 640, OU = 768, OVG = 1280;
constexpr float EPS = 1e-6f;
constexpr int NTHR = 512;
typedef unsigned short bf16;
typedef short bf16x8 __attribute__((ext_vector_type(8)));
typedef float f32x4 __attribute__((ext_vector_type(4)));
typedef unsigned u32x4 __attribute__((ext_vector_type(4)));
typedef unsigned u32x2 __attribute__((ext_vector_type(2)));
#define LAS __attribute__((address_space(3)))

constexpr size_t MiB = 1u << 20;
constexpr size_t WS_WIN = 1 * MiB;
constexpr size_t WS_WO = 5 * MiB;
constexpr size_t WS_WF1 = 7 * MiB;
constexpr size_t WS_WF2 = 18 * MiB;
constexpr size_t WS_WS = 24 * MiB;
constexpr size_t WS_ROPE = 25 * MiB;
constexpr size_t WS_ST = 26 * MiB;
constexpr size_t WS_R0 = 32 * MiB;
constexpr size_t WS_R1 = 224 * MiB;
constexpr size_t WS_R2 = 560 * MiB;
constexpr size_t WS_R3 = 752 * MiB;
constexpr size_t WS_F = 416 * MiB;
constexpr size_t WS_END = 960 * MiB;

struct Params {
    const float* xp; const float* xs;
    const float* g_mix_pre; const float* w_in; const float* sink; const float* ln_g; const float* ln_b; const float* w_s; const float* b_s;
    const float* g_attn; const float* g_gmlp; const float* w_o; const float* g_mix_post; const float* g_ffn_pre; const float* w_f1;
    const float* conv_w; const float* conv_b; const float* w_f2; const float* g_ffn_post;
    float* out; unsigned char* ws;
    int ph_lo, ph_hi;
};

__device__ __forceinline__ float bf2f(bf16 b) { return __uint_as_float((unsigned)b << 16); }
__device__ __forceinline__ unsigned f2bf(float f) { unsigned u = __float_as_uint(f); return (u + 0x7fffu + ((u >> 16) & 1u)) >> 16; }
__device__ __forceinline__ unsigned pk2(float lo, float hi) { return f2bf(lo) | (f2bf(hi) << 16); }
__device__ __forceinline__ float wave_sum(float v) {
#pragma unroll
    for (int o = 1; o < 64; o <<= 1) v += __shfl_xor(v, o);
    return v;
}
__device__ __forceinline__ const float* xrow(const Params& p, int r) { return r < T1 ? p.xp + (size_t)r * DM : p.xs + (size_t)(r - T1) * DM; }
__device__ __forceinline__ int seqlen(int r) { return r < T1 ? L1 : L2; }
__device__ __forceinline__ float gelu_exact(float x) { return 0.5f * x * (1.0f + erff(x * 0.70710678118654752f)); }

template <bool F1PERM>
__device__ __forceinline__ void transpose_item(const float* W, int K, int N, bf16* WT, LAS float* scr, int item, int lane) {
    const int nblk = N / 32, kb = item / nblk, nb = item % nblk, k0 = 64 * kb, n0 = 32 * nb;
#pragma unroll 8
    for (int i = 0; i < 32; ++i) { const int kk = 2 * i + (lane >> 5); scr[kk * 33 + (lane & 31)] = W[(size_t)(k0 + kk) * N + n0 + (lane & 31)]; }
    asm volatile("s_waitcnt lgkmcnt(0)" ::: "memory");
    const int c = lane & 7;
#pragma unroll
    for (int j = 0; j < 4; ++j) { const int n = (lane >> 3) + 8 * j; const LAS float* s = scr + (8 * c) * 33 + n;
        u32x4 o; o.x = pk2(s[0 * 33], s[1 * 33]); o.y = pk2(s[2 * 33], s[3 * 33]); o.z = pk2(s[4 * 33], s[5 * 33]); o.w = pk2(s[6 * 33], s[7 * 33]);
        int nr = n0 + n;
        if (F1PERM) { const int half = nr >= DFF ? 1 : 0, ch = nr - half * DFF; nr = (ch >> 7) * 256 + half * 128 + (ch & 127); }
        *(u32x4*)(WT + (size_t)nr * K + k0 + 8 * c) = o; }
    asm volatile("s_waitcnt lgkmcnt(0)" ::: "memory");
}
__device__ __forceinline__ void rms_row_to_bf16(const float* xr_, const float* g, bf16* orow, int lane) {
    const f32x4* xr = (const f32x4*)xr_ + lane; const f32x4* gr = (const f32x4*)g + lane;
    f32x4 v[4]; float s = 0.f;
#pragma unroll
    for (int j = 0; j < 4; ++j) { v[j] = xr[64 * j]; s += (v[j].x * v[j].x + v[j].y * v[j].y) + (v[j].z * v[j].z + v[j].w * v[j].w); }
    const float rstd = 1.f / sqrtf(wave_sum(s) * (1.f / DM) + EPS);
    u32x2* o8 = (u32x2*)orow + lane;
#pragma unroll
    for (int j = 0; j < 4; ++j) { const f32x4 gg = gr[64 * j]; u32x2 w; w.x = pk2(v[j].x * rstd * gg.x, v[j].y * rstd * gg.y); w.y = pk2(v[j].z * rstd * gg.z, v[j].w * rstd * gg.w); o8[64 * j] = w; }
}
__device__ __forceinline__ void phase_prologue(const Params& p, LAS unsigned char* lds) {
    const int tid = threadIdx.x, lane = tid & 63, wave = tid >> 6;
    LAS float* scr = (LAS float*)(lds + wave * 16384);
    const int gw = blockIdx.x * 8 + wave, NGW = gridDim.x * 8;
    bf16* WtIn = (bf16*)(p.ws + WS_WIN); bf16* WtO = (bf16*)(p.ws + WS_WO); bf16* WtF1 = (bf16*)(p.ws + WS_WF1); bf16* WtF2 = (bf16*)(p.ws + WS_WF2);
    constexpr int I_IN = (DM / 64) * (NIN / 32), I_O = (DM / 64) * (DM / 32), I_F1 = (DM / 64) * (NF1 / 32), I_F2 = (DFF / 64) * (DM / 32);
    constexpr int NITEMS = I_IN + I_O + I_F1 + I_F2;
    for (int it = gw; it < NITEMS; it += NGW) {
        int r = it;
        if (r < I_IN) { transpose_item<false>(p.w_in, DM, NIN, WtIn, scr, r, lane); continue; } r -= I_IN;
        if (r < I_O) { transpose_item<false>(p.w_o, DM, DM, WtO, scr, r, lane); continue; } r -= I_O;
        if (r < I_F1) { transpose_item<true>(p.w_f1, DM, NF1, WtF1, scr, r, lane); continue; } r -= I_F1;
        transpose_item<false>(p.w_f2, DFF, DM, WtF2, scr, r, lane);
    }
    const int gt = blockIdx.x * NTHR + tid, NGT = gridDim.x * NTHR;
    bf16* WsB = (bf16*)(p.ws + WS_WS);
    for (int i = gt; i < 8 * 128 * 128; i += NGT) WsB[i] = (bf16)f2bf(p.w_s[i]);
    float* rope = (float*)(p.ws + WS_ROPE);
    for (int i = gt; i < 8192 * 8; i += NGT) { const int pos = i >> 3, j = i & 7; const float inv = powf(500000.0f, -(float)(2 * j) / 16.0f); const float ang = (float)pos * inv; float sn, cs; sincosf(ang, &sn, &cs); rope[2 * i] = cs; rope[2 * i + 1] = sn; }
    bf16* XN = (bf16*)(p.ws + WS_R0);
    for (int m0 = gw * 4; m0 < TT; m0 += NGW * 4) {
        const f32x4* xr = (const f32x4*)xrow(p, m0) + lane; f32x4 v[4][4]; float sq[4];
#pragma unroll
        for (int k = 0; k < 4; ++k)
#pragma unroll
            for (int j = 0; j < 4; ++j) v[k][j] = xr[k * (DM / 4) + 64 * j];
#pragma unroll
        for (int k = 0; k < 4; ++k) { float s = 0.f;
#pragma unroll
            for (int j = 0; j < 4; ++j) s += (v[k][j].x * v[k][j].x + v[k][j].y * v[k][j].y) + (v[k][j].z * v[k][j].z + v[k][j].w * v[k][j].w);
            sq[k] = s; }
#pragma unroll
        for (int o = 1; o < 64; o <<= 1) {
#pragma unroll
            for (int k = 0; k < 4; ++k) sq[k] += __shfl_xor(sq[k], o); }
#pragma unroll
        for (int k = 0; k < 4; ++k) { const float rstd = 1.f / sqrtf(sq[k] * (1.f / DM) + EPS); u32x2* o8 = (u32x2*)(XN + (size_t)(m0 + k) * DM) + lane;
#pragma unroll
            for (int j = 0; j < 4; ++j) { const f32x4 gg = ((const f32x4*)p.g_mix_pre)[lane + 64 * j]; u32x2 w; w.x = pk2(v[k][j].x * rstd * gg.x, v[k][j].y * rstd * gg.y); w.y = pk2(v[k][j].z * rstd * gg.z, v[k][j].w * rstd * gg.w); o8[64 * j] = w; } }
    }
}

__device__ __forceinline__ void phase_e1(const Params& p) {
    bf16* P = (bf16*)(p.ws + WS_R1); const float* rope = (const float*)(p.ws + WS_ROPE);
    const size_t gt = (size_t)blockIdx.x * NTHR + threadIdx.x, NGT = (size_t)gridDim.x * NTHR;
    for (size_t i = gt; i < (size_t)TT * 80; i += NGT) {
        const int r = (int)(i / 80), e = (int)(i % 80), hh = e >> 3, j = e & 7; const int pos = r & (seqlen(r) - 1);
        bf16* q = P + (size_t)r * NIN + hh * 64 + j; const float x1 = bf2f(q[0]), x2 = bf2f(q[8]);
        const float cs = rope[(pos * 8 + j) * 2], sn = rope[(pos * 8 + j) * 2 + 1];
        q[0] = (bf16)f2bf(x1 * cs - x2 * sn); q[8] = (bf16)f2bf(x2 * cs + x1 * sn);
    }
    for (size_t i = gt; i < (size_t)TT * 1024; i += NGT) {
        const int r = (int)(i >> 10), c = (int)(i & 1023); bf16* q = P + (size_t)r * NIN + OU + c; q[0] = (bf16)f2bf(gelu_exact(bf2f(q[0])));
    }
}
__device__ __forceinline__ void phase_attn_naive(const Params& p) {
    const bf16* P = (const bf16*)(p.ws + WS_R1); float* AT = (float*)(p.ws + WS_R2);
    const size_t gt = (size_t)blockIdx.x * NTHR + threadIdx.x, NGT = (size_t)gridDim.x * NTHR;
    for (size_t i = gt; i < (size_t)TT * 8; i += NGT) {
        const int h = (int)(i % 8); const int r = (int)(i / 8); const int L = seqlen(r), pos = r & (L - 1), kvh = h >> 2;
        float q[64], o[64];
        const bf16* qp = P + (size_t)r * NIN + h * 64;
#pragma unroll
        for (int d = 0; d < 64; ++d) { q[d] = bf2f(qp[d]) * 0.125f; o[d] = 0.f; }
        float m = p.sink[h], l = 1.0f;
        const int k0 = pos - 128 < 0 ? 0 : pos - 128, k1 = pos + 128 > L - 1 ? L - 1 : pos + 128;
        for (int kp = k0; kp <= k1; ++kp) {
            const bf16* kr = P + (size_t)(r + kp - pos) * NIN + OK_ + kvh * 64; const bf16* vr = P + (size_t)(r + kp - pos) * NIN + OV + kvh * 64;
            float s = 0.f;
#pragma unroll
            for (int d = 0; d < 64; ++d) s += q[d] * bf2f(kr[d]);
            const float mn = fmaxf(m, s), a = __expf(m - mn), e = __expf(s - mn);
            l = l * a + e; m = mn;
#pragma unroll
            for (int d = 0; d < 64; ++d) o[d] = o[d] * a + e * bf2f(vr[d]);
        }
        const float il = 1.0f / l; float* op = AT + (size_t)r * 512 + h * 64;
#pragma unroll
        for (int d = 0; d < 64; ++d) op[d] = o[d] * il;
    }
}
__device__ __forceinline__ void phase_gmlp_stats(const Params& p) {
    const bf16* P = (const bf16*)(p.ws + WS_R1); float* ST = (float*)(p.ws + WS_ST);
    const int lane = threadIdx.x & 63, gw = blockIdx.x * 8 + (threadIdx.x >> 6), NGW = gridDim.x * 8;
    for (int r = gw; r < TT; r += NGW) {
        const bf16* v = P + (size_t)r * NIN + OVG; float x[8]; float s = 0.f;
#pragma unroll
        for (int j = 0; j < 8; ++j) { x[j] = bf2f(v[lane + 64 * j]); s += x[j]; }
        const float mu = wave_sum(s) * (1.f / 512.f); float q = 0.f;
#pragma unroll
        for (int j = 0; j < 8; ++j) { const float d = x[j] - mu; q += d * d; }
        const float rstd = 1.f / sqrtf(wave_sum(q) * (1.f / 512.f) + EPS);
        if (lane == 0) { ST[2 * r] = mu; ST[2 * r + 1] = rstd; }
    }
}
__device__ __forceinline__ void phase_gmlp_naive(const Params& p) {
    const bf16* P = (const bf16*)(p.ws + WS_R1); const float* ST = (const float*)(p.ws + WS_ST); float* GM = (float*)(p.ws + WS_R3);
    const size_t gt = (size_t)blockIdx.x * NTHR + threadIdx.x, NGT = (size_t)gridDim.x * NTHR;
    for (size_t idx = gt; idx < (size_t)TT * 512; idx += NGT) {
        const int c = (int)(idx & 511), r = (int)(idx >> 9), i = r & 127, rb = r - i, g = c >> 6;
        const float lg = p.ln_g[c], lb = p.ln_b[c]; const float* w = p.w_s + ((size_t)g * 128 + i) * 128;
        float s = 0.f;
        for (int j = 0; j < 128; ++j) { const float vv = bf2f(P[(size_t)(rb + j) * NIN + OVG + c]); s += w[j] * ((vv - ST[2 * (rb + j)]) * ST[2 * (rb + j) + 1] * lg + lb); }
        GM[idx] = bf2f(P[(size_t)r * NIN + OU + c]) * (s + p.b_s[g * 128 + i]);
    }
}
__device__ __forceinline__ void phase_mixnorm(const Params& p) {
    const float* AT = (const float*)(p.ws + WS_R2); const float* GM = (const float*)(p.ws + WS_R3); bf16* MIX = (bf16*)(p.ws + WS_R0);
    const int lane = threadIdx.x & 63, gw = blockIdx.x * 8 + (threadIdx.x >> 6), NGW = gridDim.x * 8;
    for (int r = gw; r < TT; r += NGW) {
#pragma unroll
        for (int part = 0; part < 2; ++part) {
            const float* src = (part ? GM : AT) + (size_t)r * 512; const float* g = part ? p.g_gmlp : p.g_attn;
            float x[8]; float s = 0.f;
#pragma unroll
            for (int j = 0; j < 8; ++j) { x[j] = src[lane + 64 * j]; s += x[j] * x[j]; }
            const float rstd = 1.f / sqrtf(wave_sum(s) * (1.f / 512.f) + EPS);
#pragma unroll
            for (int j = 0; j < 8; ++j) MIX[(size_t)r * DM + part * 512 + lane + 64 * j] = (bf16)f2bf(x[j] * rstd * g[lane + 64 * j]);
        }
    }
}

typedef float f32x16 __attribute__((ext_vector_type(16)));
constexpr float LOG2E = 1.4426950408889634f, C_SCALE = 0.125f * LOG2E;
constexpr int KPITCH = 144, VPITCH = 776, LDS_KO = 0, LDS_VT = 384 * KPITCH  , VNPITCH = 260, LDS_SSQ = 133120, LDS_RSTD = LDS_SSQ + 4096;
static_assert(LDS_VT + 64 * VPITCH <= LDS_SSQ && 512 * VNPITCH <= LDS_SSQ, "mixer LDS map");
__device__ __forceinline__ int crow16(int r, int h) { return (r & 3) + 8 * (r >> 2) + 4 * h; }
__device__ __forceinline__ void mix_normalize(bf16* MIXblk, const float* gain, LAS unsigned char* lds, int tid) {
    LAS float* ssq = (LAS float*)(lds + LDS_SSQ); LAS float* rstd = (LAS float*)(lds + LDS_RSTD);
    __syncthreads();
    if (tid < 128) { float s = 0.f;
#pragma unroll
        for (int hd = 0; hd < 8; ++hd) s += ssq[hd * 128 + tid];
        rstd[tid] = 1.f / sqrtf(s * (1.f / 512.f) + EPS); }
    __syncthreads();
#pragma unroll 4
    for (int i = 0; i < 16; ++i) { const int idx = tid + 512 * i, row = idx >> 6, ch = idx & 63;
        u32x4* ptr = (u32x4*)(MIXblk + (size_t)row * DM + ch * 8); const u32x4 v = *ptr; const float rs = rstd[row];
        const f32x4 g0 = *(const f32x4*)(gain + ch * 8), g1 = *(const f32x4*)(gain + ch * 8 + 4);
        u32x4 o;
        o.x = pk2(__uint_as_float(v.x << 16) * rs * g0.x, __uint_as_float(v.x & 0xffff0000u) * rs * g0.y);
        o.y = pk2(__uint_as_float(v.y << 16) * rs * g0.z, __uint_as_float(v.y & 0xffff0000u) * rs * g0.w);
        o.z = pk2(__uint_as_float(v.z << 16) * rs * g1.x, __uint_as_float(v.z & 0xffff0000u) * rs * g1.y);
        o.w = pk2(__uint_as_float(v.w << 16) * rs * g1.z, __uint_as_float(v.w & 0xffff0000u) * rs * g1.w);
        *ptr = o; }
}
__device__ __forceinline__ void attn_unit(const Params& p, LAS unsigned char* lds, int blk) {
    const int tid = threadIdx.x, lane = tid & 63, w = __builtin_amdgcn_readfirstlane(tid >> 6), r32 = lane & 31, h = lane >> 5;
    const int rb = blk * 128, L = seqlen(rb), pos0 = rb & (L - 1);
    const bool has_lo = pos0 > 0, has_hi = pos0 + 128 < L;
    const bf16* P = (const bf16*)(p.ws + WS_R1); bf16* MIX = (bf16*)(p.ws + WS_R0);
    LAS float* ssq = (LAS float*)(lds + LDS_SSQ);
    for (int kvh = 0; kvh < 2; ++kvh) {
        __syncthreads();
#pragma unroll
        for (int i = 0; i < 6; ++i) { const int idx = tid + 512 * i, key = idx >> 3, ch = idx & 7, b3 = i >> 1;
            if ((b3 == 0 && !has_lo) || (b3 == 2 && !has_hi)) continue;
            const u32x4 v = *(const u32x4*)(P + (size_t)(rb - 128 + key) * NIN + OK_ + kvh * 64 + ch * 8);
            *(LAS u32x4*)(lds + LDS_KO + key * KPITCH + ch * 16) = v; }
#pragma unroll
        for (int i = 0; i < 3; ++i) { const int idx = tid + 512 * i, kp = idx >> 3, ch = idx & 7;
            if ((i == 0 && !has_lo) || (i == 2 && !has_hi)) continue;
            const bf16* src = P + (size_t)(rb - 128 + 2 * kp) * NIN + OV + kvh * 64 + ch * 8;
            const u32x4 a = *(const u32x4*)src, b = *(const u32x4*)(src + NIN);
#pragma unroll
            for (int e = 0; e < 8; ++e) { const unsigned lo = (e & 1) ? (a[e >> 1] >> 16) : (a[e >> 1] & 0xffffu), hi = (e & 1) ? (b[e >> 1] & 0xffff0000u) : (b[e >> 1] << 16);
                *(LAS unsigned*)(lds + LDS_VT + (8 * ch + e) * VPITCH + kp * 4) = lo | hi; } }
        __syncthreads();
        const int head = kvh * 4 + (w >> 1);
        for (int qq = 0; qq < 2; ++qq) {
            const int qb = 2 * (w & 1) + qq;
            const bf16* qp = P + (size_t)(rb + 32 * qb + r32) * NIN + head * 64 + 8 * h;
            bf16x8 qr[4];
#pragma unroll
            for (int d0 = 0; d0 < 4; ++d0) qr[d0] = *(const bf16x8*)(qp + 16 * d0);
            float m = p.sink[head] * LOG2E, l = h == 0 ? 1.f : 0.f;
            f32x16 o0, o1;
#pragma unroll
            for (int r = 0; r < 16; ++r) { o0[r] = 0.f; o1[r] = 0.f; }
            const int kt_lo = has_lo ? qb : (qb > 4 ? qb : 4), kt_hi = has_hi ? qb + 8 : (qb + 8 < 7 ? qb + 8 : 7);
            for (int kt = kt_lo; kt <= kt_hi; ++kt) {
                f32x16 s;
#pragma unroll
                for (int r = 0; r < 16; ++r) s[r] = 0.f;
                const LAS unsigned char* kb = lds + LDS_KO + (32 * kt + r32) * KPITCH + 16 * h;
#pragma unroll
                for (int d0 = 0; d0 < 4; ++d0) { const bf16x8 kf = *(const LAS bf16x8*)(kb + 32 * d0); s = __builtin_amdgcn_mfma_f32_32x32x16_bf16(kf, qr[d0], s, 0, 0, 0); }
                if (kt == qb) {
#pragma unroll
                    for (int r = 0; r < 16; ++r) if (crow16(r, h) < r32) s[r] = -INFINITY;
                }
                if (kt == qb + 8) {
#pragma unroll
                    for (int r = 0; r < 16; ++r) if (crow16(r, h) > r32) s[r] = -INFINITY;
                }
                float tm = s[0];
#pragma unroll
                for (int r = 1; r < 16; ++r) tm = fmaxf(tm, s[r]);
                tm = fmaxf(tm, __shfl_xor(tm, 32));
                const float mn = fmaxf(m, tm * C_SCALE);
                if (__any(mn > m)) { const float al = __builtin_amdgcn_exp2f(m - mn); l *= al;
#pragma unroll
                    for (int r = 0; r < 16; ++r) { o0[r] *= al; o1[r] *= al; }
                    m = mn; }
                float ps = 0.f;
#pragma unroll
                for (int r = 0; r < 16; ++r) { s[r] = __builtin_amdgcn_exp2f(s[r] * C_SCALE - m); ps += s[r]; }
                l += ps;
                u32x4 pw0, pw1;
                pw0.x = pk2(s[0], s[1]); pw0.y = pk2(s[2], s[3]); pw0.z = pk2(s[4], s[5]); pw0.w = pk2(s[6], s[7]);
                pw1.x = pk2(s[8], s[9]); pw1.y = pk2(s[10], s[11]); pw1.z = pk2(s[12], s[13]); pw1.w = pk2(s[14], s[15]);
                const bf16x8 pb0 = __builtin_bit_cast(bf16x8, pw0), pb1 = __builtin_bit_cast(bf16x8, pw1);
                const LAS unsigned char* vb = lds + LDS_VT + r32 * VPITCH + (32 * kt + 4 * h) * 2;
#pragma unroll
                for (int s2 = 0; s2 < 2; ++s2) {
#pragma unroll
                    for (int db = 0; db < 2; ++db) { const LAS unsigned char* vp = vb + db * 32 * VPITCH + s2 * 32;
                        const u32x2 v0 = *(const LAS u32x2*)vp, v1 = *(const LAS u32x2*)(vp + 16);
                        const u32x4 vv = (u32x4){v0.x, v0.y, v1.x, v1.y}; const bf16x8 vf = __builtin_bit_cast(bf16x8, vv);
                        if (db == 0) o0 = __builtin_amdgcn_mfma_f32_32x32x16_bf16(vf, s2 ? pb1 : pb0, o0, 0, 0, 0);
                        else o1 = __builtin_amdgcn_mfma_f32_32x32x16_bf16(vf, s2 ? pb1 : pb0, o1, 0, 0, 0); }
                }
            }
            l += __shfl_xor(l, 32);
            const float inv = 1.f / l; float ss = 0.f;
#pragma unroll
            for (int r = 0; r < 16; ++r) { o0[r] *= inv; o1[r] *= inv; ss += o0[r] * o0[r] + o1[r] * o1[r]; }
            ss += __shfl_xor(ss, 32);
            if (h == 0) ssq[head * 128 + 32 * qb + r32] = ss;
            bf16* op = MIX + (size_t)(rb + 32 * qb + r32) * DM + head * 64 + 4 * h;
#pragma unroll
            for (int g = 0; g < 4; ++g) { u32x2 wv; wv.x = pk2(o0[4 * g], o0[4 * g + 1]); wv.y = pk2(o0[4 * g + 2], o0[4 * g + 3]); *(u32x2*)(op + 8 * g) = wv;
                wv.x = pk2(o1[4 * g], o1[4 * g + 1]); wv.y = pk2(o1[4 * g + 2], o1[4 * g + 3]); *(u32x2*)(op + 32 + 8 * g) = wv; }
        }
    }
    mix_normalize(MIX + (size_t)rb * DM, p.g_attn, lds, tid);
}
__device__ __forceinline__ void gmlp_unit(const Params& p, LAS unsigned char* lds, int blk) {
    const int tid = threadIdx.x, lane = tid & 63, w = __builtin_amdgcn_readfirstlane(tid >> 6), r32 = lane & 31, h = lane >> 5;
    const int rb = blk * 128;
    const bf16* P = (const bf16*)(p.ws + WS_R1); bf16* MIX = (bf16*)(p.ws + WS_R0); const bf16* WsB = (const bf16*)(p.ws + WS_WS);
    LAS float* ssq = (LAS float*)(lds + LDS_SSQ);
    __syncthreads();
    for (int pr = 0; pr < 8; ++pr) { const int j0 = 16 * w + 2 * pr; const bf16* va = P + (size_t)(rb + j0) * NIN + OVG + lane; const bf16* vb = va + NIN;
        float a[8], b[8]; float sa = 0.f, sb = 0.f;
#pragma unroll
        for (int e = 0; e < 8; ++e) { a[e] = bf2f(va[64 * e]); b[e] = bf2f(vb[64 * e]); sa += a[e]; sb += b[e]; }
        const float ma = wave_sum(sa) * (1.f / 512.f), mb = wave_sum(sb) * (1.f / 512.f); float qa = 0.f, qb_ = 0.f;
#pragma unroll
        for (int e = 0; e < 8; ++e) { a[e] -= ma; b[e] -= mb; qa += a[e] * a[e]; qb_ += b[e] * b[e]; }
        const float ra = 1.f / sqrtf(wave_sum(qa) * (1.f / 512.f) + EPS), rbs = 1.f / sqrtf(wave_sum(qb_) * (1.f / 512.f) + EPS);
#pragma unroll
        for (int e = 0; e < 8; ++e) { const int c = lane + 64 * e; const float lg = p.ln_g[c], lb = p.ln_b[c];
            *(LAS unsigned*)(lds + c * VNPITCH + j0 * 2) = pk2(a[e] * ra * lg + lb, b[e] * rbs * lg + lb); }
    }
    __syncthreads();
    const int g = w;
    for (int ib = 0; ib < 4; ++ib) {
        bf16x8 bfr[8];
#pragma unroll
        for (int ks = 0; ks < 8; ++ks) bfr[ks] = *(const bf16x8*)(WsB + ((size_t)g * 128 + 32 * ib + r32) * 128 + 16 * ks + 8 * h);
        const int row = rb + 32 * ib + r32; const float bsv = p.b_s[g * 128 + 32 * ib + r32]; float ss = 0.f;
#pragma unroll
        for (int db = 0; db < 2; ++db) {
            f32x16 acc;
#pragma unroll
            for (int r = 0; r < 16; ++r) acc[r] = 0.f;
#pragma unroll
            for (int ks = 0; ks < 8; ++ks) { const LAS unsigned* ap = (const LAS unsigned*)(lds + (64 * g + 32 * db + r32) * VNPITCH + (16 * ks + 8 * h) * 2);
                const u32x4 av = (u32x4){ap[0], ap[1], ap[2], ap[3]}; acc = __builtin_amdgcn_mfma_f32_32x32x16_bf16(__builtin_bit_cast(bf16x8, av), bfr[ks], acc, 0, 0, 0); }
            const bf16* up = P + (size_t)row * NIN + OU + 64 * g + 32 * db + 4 * h; bf16* op = MIX + (size_t)row * DM + 512 + 64 * g + 32 * db + 4 * h;
#pragma unroll
            for (int gq = 0; gq < 4; ++gq) { const u32x2 uu = *(const u32x2*)(up + 8 * gq);
                const float o0 = __uint_as_float(uu.x << 16) * (acc[4 * gq] + bsv), o1 = __uint_as_float(uu.x & 0xffff0000u) * (acc[4 * gq + 1] + bsv);
                const float o2 = __uint_as_float(uu.y << 16) * (acc[4 * gq + 2] + bsv), o3 = __uint_as_float(uu.y & 0xffff0000u) * (acc[4 * gq + 3] + bsv);
                ss += (o0 * o0 + o1 * o1) + (o2 * o2 + o3 * o3);
                u32x2 wv; wv.x = pk2(o0, o1); wv.y = pk2(o2, o3); *(u32x2*)(op + 8 * gq) = wv; }
        }
        ss += __shfl_xor(ss, 32);
        if (h == 0) ssq[g * 128 + 32 * ib + r32] = ss;
    }
    mix_normalize(MIX + (size_t)rb * DM + 512, p.g_gmlp, lds, tid);
}
__device__ __forceinline__ void phase_mixer(const Params& p, LAS unsigned char* lds) {
    for (int u = blockIdx.x; u < TT / 128; u += gridDim.x) attn_unit(p, lds, u);
    for (int u = blockIdx.x; u < TT / 128; u += gridDim.x) gmlp_unit(p, lds, u);
    __syncthreads();
}
__device__ __forceinline__ f32x4 bfx4(u32x2 w) { return (f32x4){__uint_as_float(w.x << 16), __uint_as_float(w.x & 0xffff0000u), __uint_as_float(w.y << 16), __uint_as_float(w.y & 0xffff0000u)}; }
__device__ __forceinline__ float sq4(f32x4 v) { return (v.x * v.x + v.y * v.y) + (v.z * v.z + v.w * v.w); }
__device__ __forceinline__ void phase_r3(const Params& p) {
    const bf16* M = (const bf16*)(p.ws + WS_R1); bf16* H2 = (bf16*)(p.ws + WS_R0);
    const int lane = threadIdx.x & 63, gw = blockIdx.x * 8 + (threadIdx.x >> 6), NGW = gridDim.x * 8;
    constexpr int NR = 2;
    for (int r0 = gw * NR; r0 < TT; r0 += NGW * NR) {
        const f32x4* xr = (const f32x4*)xrow(p, r0) + lane; const u32x2* mr = (const u32x2*)(M + (size_t)r0 * DM) + lane;
        f32x4 mv[NR][4], xv[NR][4]; float s[NR], s2[NR];
#pragma unroll
        for (int k = 0; k < NR; ++k)
#pragma unroll
            for (int j = 0; j < 4; ++j) { xv[k][j] = xr[k * (DM / 4) + 64 * j]; mv[k][j] = bfx4(mr[k * (DM / 4) + 64 * j]); }
#pragma unroll
        for (int k = 0; k < NR; ++k) { s[k] = 0.f;
#pragma unroll
            for (int j = 0; j < 4; ++j) s[k] += sq4(mv[k][j]); }
#pragma unroll
        for (int o = 1; o < 64; o <<= 1) {
#pragma unroll
            for (int k = 0; k < NR; ++k) s[k] += __shfl_xor(s[k], o); }
#pragma unroll
        for (int k = 0; k < NR; ++k) { const float rstd = 1.f / sqrtf(s[k] * (1.f / DM) + EPS); s2[k] = 0.f; f32x4* orow = (f32x4*)(p.out + (size_t)(r0 + k) * DM) + lane;
#pragma unroll
            for (int j = 0; j < 4; ++j) { const f32x4 g = ((const f32x4*)p.g_mix_post)[lane + 64 * j]; xv[k][j] = xv[k][j] + mv[k][j] * rstd * g; orow[64 * j] = xv[k][j]; s2[k] += sq4(xv[k][j]); } }
#pragma unroll
        for (int o = 1; o < 64; o <<= 1) {
#pragma unroll
            for (int k = 0; k < NR; ++k) s2[k] += __shfl_xor(s2[k], o); }
#pragma unroll
        for (int k = 0; k < NR; ++k) { const float rstd2 = 1.f / sqrtf(s2[k] * (1.f / DM) + EPS); u32x2* o8 = (u32x2*)(H2 + (size_t)(r0 + k) * DM) + lane;
#pragma unroll
            for (int j = 0; j < 4; ++j) { const f32x4 g = ((const f32x4*)p.g_ffn_pre)[lane + 64 * j]; u32x2 w; w.x = pk2(xv[k][j].x * rstd2 * g.x, xv[k][j].y * rstd2 * g.y); w.y = pk2(xv[k][j].z * rstd2 * g.z, xv[k][j].w * rstd2 * g.w); o8[64 * j] = w; } }
    }
}
constexpr int ZCH = 16384;
__device__ __forceinline__ void phase_conv_naive(const Params& p, int chunk) {
    const bf16* Z = (const bf16*)(p.ws + WS_R1); bf16* F = (bf16*)(p.ws + WS_F);
    const size_t gt = (size_t)blockIdx.x * NTHR + threadIdx.x, NGT = (size_t)gridDim.x * NTHR;
    for (size_t idx = gt; idx < (size_t)ZCH * DFF; idx += NGT) {
        const int c = (int)(idx % DFF), lr = (int)(idx / DFF), r = chunk * ZCH + lr; const int L = seqlen(r), pos = r & (L - 1);
        const int cg_ = (c >> 7) * 256 + (c & 127), cu = cg_ + 128;
        const bf16* z = Z + (size_t)lr * NF1;
        const bool hl = pos > 0, hr = pos < L - 1;
        const float g0 = hl ? bf2f(z[cg_ - NF1]) : 0.f, g1 = bf2f(z[cg_]), g2 = hr ? bf2f(z[cg_ + NF1]) : 0.f;
        const float u0 = hl ? bf2f(z[cu - NF1]) : 0.f, u1 = bf2f(z[cu]), u2 = hr ? bf2f(z[cu + NF1]) : 0.f;
        const float* cw = p.conv_w;
        const float gg = g0 * cw[c] + g1 * cw[NF1 + c] + g2 * cw[2 * NF1 + c] + p.conv_b[c];
        const float uu = u0 * cw[DFF + c] + u1 * cw[NF1 + DFF + c] + u2 * cw[2 * NF1 + DFF + c] + p.conv_b[DFF + c];
        const float sl = gg / (1.0f + __expf(-gg));
        F[(size_t)r * DFF + c] = (bf16)f2bf(sl * uu);
    }
}
__device__ __forceinline__ void phase_r6(const Params& p) {
    const bf16* Y = (const bf16*)(p.ws + WS_R0);
    const int lane = threadIdx.x & 63, gw = blockIdx.x * 8 + (threadIdx.x >> 6), NGW = gridDim.x * 8;
    constexpr int NR = 2;
    for (int r0 = gw * NR; r0 < TT; r0 += NGW * NR) {
        const u32x2* mr = (const u32x2*)(Y + (size_t)r0 * DM) + lane; f32x4* orow = (f32x4*)(p.out + (size_t)r0 * DM) + lane;
        f32x4 mv[NR][4], xv[NR][4]; float s[NR];
#pragma unroll
        for (int k = 0; k < NR; ++k)
#pragma unroll
            for (int j = 0; j < 4; ++j) { xv[k][j] = orow[k * (DM / 4) + 64 * j]; mv[k][j] = bfx4(mr[k * (DM / 4) + 64 * j]); }
#pragma unroll
        for (int k = 0; k < NR; ++k) { s[k] = 0.f;
#pragma unroll
            for (int j = 0; j < 4; ++j) s[k] += sq4(mv[k][j]); }
#pragma unroll
        for (int o = 1; o < 64; o <<= 1) {
#pragma unroll
            for (int k = 0; k < NR; ++k) s[k] += __shfl_xor(s[k], o); }
#pragma unroll
        for (int k = 0; k < NR; ++k) { const float rstd = 1.f / sqrtf(s[k] * (1.f / DM) + EPS);
#pragma unroll
            for (int j = 0; j < 4; ++j) { const f32x4 g = ((const f32x4*)p.g_ffn_post)[lane + 64 * j]; orow[k * (DM / 4) + 64 * j] = xv[k][j] + mv[k][j] * rstd * g; } }
    }
}

constexpr int LDS_BYTES = 147456;
template <class Epi>
__device__ __forceinline__ void run_gemm(LAS unsigned char* lds, const bf16* A, const bf16* Bt, int M, int N, int K, const Epi& E) {
    pg8::Gemm g{A, Bt, M, N, K}; pg8::StaticOrder S; S.init(M, N, (int)gridDim.x, (int)blockIdx.x);
    pg8::gemm_phase<Epi, pg8::StaticOrder, true, true>(lds, g, S, E);
}
constexpr int NPHASE = 22;
__global__ void __launch_bounds__(NTHR, 2) mega_fwd(Params p) {
    extern __shared__ __attribute__((aligned(16))) unsigned char lds_raw[];
    LAS unsigned char* lds = (LAS unsigned char*)lds_raw;
    cg::grid_group grid = cg::this_grid();
    unsigned char* ws = p.ws;
    const int lo = p.ph_lo, hi = p.ph_hi;
#define IN(k) (lo <= (k) && (k) < hi)
#define SEAM(k) do { if (IN(k) && IN((k) + 1)) grid.sync(); } while (0)
    if (IN(0)) phase_prologue(p, lds);
    if constexpr ((PROBE_MASK >> 0) & 1) { grid.sync(); if (IN(0)) phase_prologue(p, lds); }
    SEAM(0);
#if defined(E1_NAIVE)
    if (IN(1)) { pg8::EpiBf16<0> E{(bf16*)(ws + WS_R1), NIN, nullptr, 0, 0, 1.f}; run_gemm(lds, (const bf16*)(ws + WS_R0), (const bf16*)(ws + WS_WIN), TT, NIN, DM, E); }
    SEAM(1);
    if (IN(2)) phase_e1(p);
    SEAM(2);
#else
    if (IN(1)) { pg8::EpiInProj E{(bf16*)(ws + WS_R1), NIN, (const float*)(ws + WS_ROPE), T1}; run_gemm(lds, (const bf16*)(ws + WS_R0), (const bf16*)(ws + WS_WIN), TT, NIN, DM, E); }
    if constexpr ((PROBE_MASK >> 1) & 1) { grid.sync(); if (IN(1)) { pg8::EpiInProj E{(bf16*)(ws + WS_R1), NIN, (const float*)(ws + WS_ROPE), T1}; run_gemm(lds, (const bf16*)(ws + WS_R0), (const bf16*)(ws + WS_WIN), TT, NIN, DM, E); } }
    if (IN(1) && IN(3)) grid.sync();
#endif
#if defined(MIXER_NAIVE)
    if (IN(3)) { phase_attn_naive(p); phase_gmlp_stats(p); }
    SEAM(3);
    if (IN(4)) phase_gmlp_naive(p);
    SEAM(4);
    if (IN(5)) phase_mixnorm(p);
    SEAM(5);
#else
    if (IN(3)) phase_mixer(p, lds);
    if constexpr ((PROBE_MASK >> 2) & 1) { grid.sync(); if (IN(3)) phase_mixer(p, lds); }
    if (IN(3) && IN(6)) grid.sync();
#endif
    if (IN(6)) { pg8::EpiBf16<0> E{(bf16*)(ws + WS_R1), DM, nullptr, 0, 0, 1.f}; run_gemm(lds, (const bf16*)(ws + WS_R0), (const bf16*)(ws + WS_WO), TT, DM, DM, E); }
    if constexpr ((PROBE_MASK >> 3) & 1) { grid.sync(); if (IN(6)) { pg8::EpiBf16<0> E{(bf16*)(ws + WS_R1), DM, nullptr, 0, 0, 1.f}; run_gemm(lds, (const bf16*)(ws + WS_R0), (const bf16*)(ws + WS_WO), TT, DM, DM, E); } }
    SEAM(6);
    if (IN(7)) phase_r3(p);
    if constexpr ((PROBE_MASK >> 4) & 1) { grid.sync(); if (IN(7)) phase_r3(p); }
    SEAM(7);
#if defined(CONV_NAIVE)
    for (int c = 0; c < 6; ++c) {
        if (IN(8 + 2 * c)) { pg8::EpiBf16<0> E{(bf16*)(ws + WS_R1), NF1, nullptr, 0, 0, 1.f}; run_gemm(lds, (const bf16*)(ws + WS_R0) + (size_t)c * ZCH * DM, (const bf16*)(ws + WS_WF1), ZCH, NF1, DM, E); }
        SEAM(8 + 2 * c);
        if (IN(9 + 2 * c)) phase_conv_naive(p, c);
        SEAM(9 + 2 * c);
    }
#else
    if (IN(8)) { pg8::EpiConvSilu E{(bf16*)(ws + WS_F), p.conv_w, p.conv_b, DFF, TT, T1};
        pg8::Gemm g{(const bf16*)(ws + WS_R0) - DM, (const bf16*)(ws + WS_WF1), 391 * 256, NF1, DM, 126, 4, 252, 1};
        pg8::StaticOrder S; S.init(391 * 256, NF1, (int)gridDim.x, (int)blockIdx.x);
        pg8::gemm_phase<pg8::EpiConvSilu, pg8::StaticOrder, true, true>(lds, g, S, E); }
    if constexpr ((PROBE_MASK >> 5) & 1) { grid.sync(); if (IN(8)) { pg8::EpiConvSilu E{(bf16*)(ws + WS_F), p.conv_w, p.conv_b, DFF, TT, T1};
        pg8::Gemm g{(const bf16*)(ws + WS_R0) - DM, (const bf16*)(ws + WS_WF1), 391 * 256, NF1, DM, 126, 4, 252, 1};
        pg8::StaticOrder S; S.init(391 * 256, NF1, (int)gridDim.x, (int)blockIdx.x);
        pg8::gemm_phase<pg8::EpiConvSilu, pg8::StaticOrder, true, true>(lds, g, S, E); } }
    if (IN(8) && IN(20)) grid.sync();
#endif
    if (IN(20)) { pg8::EpiBf16<0> E{(bf16*)(ws + WS_R0), DM, nullptr, 0, 0, 1.f}; run_gemm(lds, (const bf16*)(ws + WS_F), (const bf16*)(ws + WS_WF2), TT, DM, DFF, E); }
    if constexpr ((PROBE_MASK >> 6) & 1) { grid.sync(); if (IN(20)) { pg8::EpiBf16<0> E{(bf16*)(ws + WS_R0), DM, nullptr, 0, 0, 1.f}; run_gemm(lds, (const bf16*)(ws + WS_F), (const bf16*)(ws + WS_WF2), TT, DM, DFF, E); } }
    SEAM(20);
    if (IN(21)) phase_r6(p);
}

extern "C" void kernel_launch(void* const* d_in, const int* in_sizes, int n_in, void* d_out, int out_size, void* d_ws, size_t ws_size, hipStream_t stream) {
    static int grid = 0;
    if (grid == 0) {
        if (n_in != 19 || out_size != TT * DM || ws_size < WS_END) { fprintf(stderr, "kernel_launch: unexpected shapes n_in %d out %d ws %zu\n", n_in, out_size, ws_size); grid = -1; return; }
        int dev = 0, cus = 0, per_cu = 0;
        (void)hipGetDevice(&dev); (void)hipDeviceGetAttribute(&cus, hipDeviceAttributeMultiprocessorCount, dev);
        if (hipFuncSetAttribute((const void*)mega_fwd, hipFuncAttributeMaxDynamicSharedMemorySize, LDS_BYTES) != hipSuccess) { fprintf(stderr, "hipFuncSetAttribute failed\n"); grid = -1; return; }
        if (hipOccupancyMaxActiveBlocksPerMultiprocessor(&per_cu, (const void*)mega_fwd, NTHR, LDS_BYTES) != hipSuccess || per_cu < 1) { fprintf(stderr, "occupancy query: %d\n", per_cu); per_cu = 1; }
        (void)hipGetLastError();
        grid = cus * 1;
    }
    if (grid < 0) return;
    Params p{};
    p.xp = (const float*)d_in[0]; p.xs = (const float*)d_in[1]; p.g_mix_pre = (const float*)d_in[2]; p.w_in = (const float*)d_in[3]; p.sink = (const float*)d_in[4];
    p.ln_g = (const float*)d_in[5]; p.ln_b = (const float*)d_in[6]; p.w_s = (const float*)d_in[7]; p.b_s = (const float*)d_in[8]; p.g_attn = (const float*)d_in[9];
    p.g_gmlp = (const float*)d_in[10]; p.w_o = (const float*)d_in[11]; p.g_mix_post = (const float*)d_in[12]; p.g_ffn_pre = (const float*)d_in[13]; p.w_f1 = (const float*)d_in[14];
    p.conv_w = (const float*)d_in[15]; p.conv_b = (const float*)d_in[16]; p.w_f2 = (const float*)d_in[17]; p.g_ffn_post = (const float*)d_in[18];
    p.out = (float*)d_out; p.ws = (unsigned char*)d_ws;
#if defined(MULTI_LAUNCH)
    for (int ph = 0; ph < NPHASE; ++ph) { p.ph_lo = ph; p.ph_hi = ph + 1; hipLaunchKernelGGL(mega_fwd, dim3(grid), dim3(NTHR), LDS_BYTES, stream, p); }
#else
    p.ph_lo = 0; p.ph_hi = NPHASE;
    void* args[] = {&p};
    hipError_t e = hipLaunchCooperativeKernel((const void*)mega_fwd, dim3(grid), dim3(NTHR), args, LDS_BYTES, stream);
    if (e != hipSuccess) fprintf(stderr, "cooperative launch failed: %s (grid %d)\n", hipGetErrorString(e), grid);
#endif
}
```
